# Optimizing an MI355X kernel written in HIP

```python
import jax, jax.numpy as jnp
from jax import lax
import numpy as np

D_MODEL = 1024
BATCH = 8
SEQ = 2048
DEPTH = 2
DEC_BATCH = 128
DEC_SEQ = 4
PAST_LEN = 16384
PAGE_SIZE = 128

BRANCH_W = D_MODEL // 2
N_BRANCH = 3
LRU_W = BRANCH_W
LRU_BLOCKS = 8
LRU_BW = LRU_W // LRU_BLOCKS
CONV_W = 4
LRU_C = 8.0
HG_HEADS = 4
HG_DK = BRANCH_W // HG_HEADS
HG_DV = BRANCH_W // HG_HEADS
HG_CHUNK = 64
HG_F_MIN = 1e-20
RW_HD = 64
RW_HEADS = BRANCH_W // RW_HD
RW_LORA_W = 64
RW_LORA_A = 64
RW_LORA_G = 128
RW_GN_EPS = 64e-5
RW_COLS = 3 * BRANCH_W + RW_LORA_W + RW_LORA_A + RW_LORA_G
D_FF = ((8 * D_MODEL // 3 + 255) // 256) * 256
PLE_DIM = 256
EPS = 1e-6
IN_SPLIT = (LRU_W, LRU_W, HG_HEADS * HG_DK, HG_HEADS * HG_DK, HG_HEADS * HG_DV, HG_HEADS * HG_DV, RW_COLS, N_BRANCH * D_MODEL)
IN_COLS = sum(IN_SPLIT)

kernel_name = 'hybrid_rglru_hgrn2_rwkv7_step'


def _f32(t):
    return t.astype(jnp.float32)


def _split(t, sizes):
    idx = [int(i) for i in np.cumsum(sizes)[:-1]]
    return jnp.split(t, idx, axis=-1)


def rmsnorm(x, g):
    xf = _f32(x)
    y = xf * lax.rsqrt(jnp.mean(xf * xf, axis=-1, keepdims=True) + EPS)
    return (y * _f32(g)).astype(x.dtype)


def rglru_branch(xa, ga, conv_state, h0, pos, conv_w, conv_b, wa, ba, wx, bx, lam):
    B, S, W = xa.shape
    xcat = jnp.concatenate([_f32(conv_state), _f32(xa)], axis=1)
    cw = _f32(conv_w)
    xc = _f32(conv_b) + xcat[:, 0:S] * cw[0]
    for j in range(1, CONV_W):
        xc = xc + xcat[:, j:j + S] * cw[j]
    new_conv = xcat[:, S:]
    xb = xc.reshape(B, S, LRU_BLOCKS, LRU_BW)
    r = jax.nn.sigmoid(jnp.einsum('bshi,hij->bshj', xb, _f32(wa)).reshape(B, S, W) + _f32(ba))
    i = jax.nn.sigmoid(jnp.einsum('bshi,hij->bshj', xb, _f32(wx)).reshape(B, S, W) + _f32(bx))
    log_a = -LRU_C * r * jax.nn.softplus(-_f32(lam))
    a = jnp.exp(log_a)
    mult = jnp.where((pos == 0)[None, :, None], 1.0, jnp.sqrt(jnp.maximum(-jnp.expm1(2.0 * log_a), 0.0)))
    b = xc * i * mult
    b = b.at[:, 0].add(a[:, 0] * _f32(h0))

    def comb(e, l):
        return (e[0] * l[0], l[0] * e[1] + l[1])

    _, h = lax.associative_scan(comb, (a, b), axis=1)
    y = h * jax.nn.gelu(_f32(ga), approximate=True)
    return y, new_conv, h[:, -1]


def hgrn2_branch(q, f_pre, v, g, s0, lb, norm_g):
    B, S, _ = q.shape
    C = HG_CHUNK if S % HG_CHUNK == 0 else S
    N = S // C
    q = jax.nn.silu(_f32(q))
    lb = _f32(lb)
    fp = _f32(f_pre)
    f = lb + (1.0 - lb) * jax.nn.sigmoid(fp)
    k = (1.0 - lb) * jax.nn.sigmoid(-fp)
    logf = jnp.log(jnp.maximum(f, HG_F_MIN))

    def chunks(t, d):
        return jnp.moveaxis(t.reshape(B, N, C, HG_HEADS, d), 1, 0)

    xs = (chunks(q, HG_DK), chunks(k, HG_DK), chunks(_f32(v), HG_DV), chunks(logf, HG_DK))
    causal = jnp.tril(jnp.ones((C, C), bool))

    def step(st, inp):
        qc, kc, vc, lc = inp
        bc = jnp.cumsum(lc, axis=1)
        diff = bc[:, :, None] - bc[:, None, :]
        dec = jnp.where(causal[None, :, :, None, None], jnp.exp(jnp.minimum(diff, 0.0)), 0.0)
        A = jnp.einsum('bthk,bshk,btshk->bhts', qc, kc, dec)
        o = jnp.einsum('bhts,bshv->bthv', A, vc) + jnp.einsum('bthk,bhkv->bthv', qc * jnp.exp(bc), st)
        btot = bc[:, -1]
        st = jnp.exp(btot)[..., None] * st + jnp.einsum('bshk,bshv->bhkv', kc * jnp.exp(btot[:, None] - bc), vc)
        return st, o

    s_new, o = lax.scan(step, _f32(s0), xs)
    o = jnp.moveaxis(o, 0, 1).reshape(B, S, HG_HEADS, HG_DV)
    o = o * lax.rsqrt(jnp.mean(o * o, axis=-1, keepdims=True) + EPS) * _f32(norm_g).reshape(HG_HEADS, HG_DV)
    y = o.reshape(B, S, HG_HEADS * HG_DV) * jax.nn.silu(_f32(g))
    return y, s_new


def rwkv7_branch(cblk, shift0, s0, mu, w0, w_up, a0, a_up, g_up, k_k, k_a, r_k, ln_g, ln_b):
    B, S, _ = cblk.shape
    c = _f32(cblk)
    prev = jnp.concatenate([_f32(shift0)[:, None], c[:, :-1]], axis=1)
    xm = c + (prev - c) * _f32(mu)
    new_shift = c[:, -1]
    r, k, v, wl, al, gl = _split(xm, (BRANCH_W, BRANCH_W, BRANCH_W, RW_LORA_W, RW_LORA_A, RW_LORA_G))
    w = -jax.nn.softplus(-(_f32(w0) + jnp.tanh(wl) @ _f32(w_up))) - 0.5
    decay = jnp.exp(-jnp.exp(w))
    a = jax.nn.sigmoid(_f32(a0) + al @ _f32(a_up))
    g = jax.nn.sigmoid(gl) @ _f32(g_up)

    def heads(t):
        return t.reshape(B, S, RW_HEADS, RW_HD)

    kk = heads(k * _f32(k_k))
    kk = kk / jnp.maximum(jnp.sqrt(jnp.sum(kk * kk, axis=-1, keepdims=True)), 1e-12)
    k = k * (1.0 + (a - 1.0) * _f32(k_a))
    rh, kh, vh, ah, dh = heads(r), heads(k), heads(v), heads(a), heads(decay)

    def step(st, inp):
        rt, wt, kt, vt, kkt, at = inp
        sk = jnp.einsum('bhvk,bhk->bhv', st, kkt)
        st = st * wt[:, :, None, :] - sk[..., None] * (kkt * at)[:, :, None, :] + vt[..., None] * kt[:, :, None, :]
        o = jnp.einsum('bhvk,bhk->bhv', st, rt)
        return st, o

    xs = tuple(jnp.moveaxis(t, 1, 0) for t in (rh, dh, kh, vh, kk, ah))
    s_new, o = lax.scan(step, _f32(s0), xs)
    o = jnp.moveaxis(o, 0, 1)
    mean = jnp.mean(o, axis=-1, keepdims=True)
    var = jnp.mean((o - mean) ** 2, axis=-1, keepdims=True)
    o = (o - mean) * lax.rsqrt(var + RW_GN_EPS) * _f32(ln_g).reshape(RW_HEADS, RW_HD) + _f32(ln_b).reshape(RW_HEADS, RW_HD)
    o = o + jnp.sum(rh * kh * _f32(r_k), axis=-1, keepdims=True) * vh
    y = o.reshape(B, S, BRANCH_W) * g
    return y, s_new, new_shift


def decoder_layer(x, p, st, pos, lb, L):
    conv0, lru0, hg0, rw0, sh0 = st
    B, S, _ = x.shape
    dt = x.dtype
    h = rmsnorm(x, L['norm_pre_mix'])
    proj = jnp.einsum('bsd,dc->bsc', h, L['w_in'])
    xa, ga, bq, bf, bi, bg, cblk, gts = _split(proj, IN_SPLIT)
    yA, nconv, nlru = rglru_branch(xa, ga, conv0, lru0, pos, L['conv_w'], L['conv_b'], L['lru_wa'], L['lru_ba'], L['lru_wx'], L['lru_bx'], L['lru_lambda'])
    yB, nhg = hgrn2_branch(bq, bf, bi, bg, hg0, lb, L['hg_norm_g'])
    yC, nrw, nsh = rwkv7_branch(cblk, sh0, rw0, L['rw_mu'], L['rw_w0'], L['rw_w_up'], L['rw_a0'], L['rw_a_up'], L['rw_g_up'], L['rw_k_k'], L['rw_k_a'], L['rw_r_k'], L['rw_ln_g'], L['rw_ln_b'])
    br = jnp.stack([yA, yB, yC], axis=2).astype(dt)
    up = jnp.einsum('bsnw,nwd->bsnd', br, L['w_branch'])
    gates = jax.nn.sigmoid(gts.reshape(B, S, N_BRANCH, D_MODEL))
    mix = jnp.einsum('bsd,de->bse', jnp.sum(gates * up, axis=2), L['w_out'])
    x = x + rmsnorm(mix, L['norm_post_mix'])
    h = rmsnorm(x, L['norm_pre_ffn'])
    ff = (jax.nn.silu(h @ L['w_ffn_gate']) * (h @ L['w_ffn_up'])) @ L['w_ffn_down']
    x = x + rmsnorm(ff, L['norm_post_ffn'])
    ple = (p @ L['w_ple']) * jax.nn.sigmoid(x @ L['w_ple_gate'])
    x = x + rmsnorm(ple, L['norm_ple'])
    return x, (nconv.astype(conv0.dtype), nlru.astype(lru0.dtype), nhg.astype(hg0.dtype), nrw.astype(rw0.dtype), nsh.astype(sh0.dtype))


def run_trunk(x, p, states, pos, lb_all, W):
    new = ([], [], [], [], [])
    for i in range(DEPTH):
        Li = {name: w[i] for name, w in W.items()}
        x, ns = decoder_layer(x, p[i], tuple(s[i] for s in states), pos, lb_all[i], Li)
        for lst, t in zip(new, ns):
            lst.append(t)
    return x, tuple(jnp.stack(l) for l in new)


def setup_inputs(seed: int = 0) -> dict:
    key = jax.random.key(seed)
    ks = iter(jax.random.split(key, 64))
    f32 = jnp.float32

    def nrm(shape, scale):
        return scale * jax.random.normal(next(ks), shape, f32)

    def gain(shape):
        return 1.0 + 0.05 * jax.random.normal(next(ks), shape, f32)

    def unif(shape, lo, hi):
        return jax.random.uniform(next(ks), shape, f32, lo, hi)

    u = unif((DEPTH, LRU_W), 0.9, 0.999)
    s = u ** (1.0 / LRU_C)
    lam = jnp.log(s) - jnp.log1p(-s)
    return {
        'x_prompt': nrm((BATCH, SEQ, D_MODEL), 1.0),
        'x_sample': nrm((DEC_BATCH, DEC_SEQ, D_MODEL), 1.0),
        'p_prompt': nrm((DEPTH, BATCH, SEQ, PLE_DIM), 1.0),
        'p_sample': nrm((DEPTH, DEC_BATCH, DEC_SEQ, PLE_DIM), 1.0),
        'state_conv_a': nrm((DEPTH, DEC_BATCH, CONV_W - 1, LRU_W), 1.0),
        'state_lru_a': nrm((DEPTH, DEC_BATCH, LRU_W), 0.5),
        'state_hgrn': nrm((DEPTH, DEC_BATCH, HG_HEADS, HG_DK, HG_DV), 0.5),
        'state_rwkv': nrm((DEPTH, DEC_BATCH, RW_HEADS, RW_HD, RW_HD), 0.3),
        'state_shift_c': nrm((DEPTH, DEC_BATCH, RW_COLS), 1.0),
        'norm_pre_mix': gain((DEPTH, D_MODEL)),
        'w_in': nrm((DEPTH, D_MODEL, IN_COLS), D_MODEL ** -0.5),
        'conv_w': nrm((DEPTH, CONV_W, LRU_W), CONV_W ** -0.5),
        'conv_b': nrm((DEPTH, LRU_W), 0.02),
        'lru_wa': nrm((DEPTH, LRU_BLOCKS, LRU_BW, LRU_BW), LRU_BW ** -0.5),
        'lru_ba': nrm((DEPTH, LRU_W), 0.02),
        'lru_wx': nrm((DEPTH, LRU_BLOCKS, LRU_BW, LRU_BW), LRU_BW ** -0.5),
        'lru_bx': nrm((DEPTH, LRU_W), 0.02),
        'lru_lambda': lam,
        'hg_lower_bounds': nrm((DEPTH, HG_HEADS * HG_DK), 1.0),
        'hg_norm_g': gain((DEPTH, HG_HEADS * HG_DV)),
        'rw_mu': unif((DEPTH, RW_COLS), 0.0, 1.0),
        'rw_w0': unif((DEPTH, BRANCH_W), -6.0, 1.0),
        'rw_w_up': nrm((DEPTH, RW_LORA_W, BRANCH_W), 0.5 * RW_LORA_W ** -0.5),
        'rw_a0': nrm((DEPTH, BRANCH_W), 0.5),
        'rw_a_up': nrm((DEPTH, RW_LORA_A, BRANCH_W), RW_LORA_A ** -0.5),
        'rw_g_up': nrm((DEPTH, RW_LORA_G, BRANCH_W), RW_LORA_G ** -0.5),
        'rw_k_k': 0.85 + nrm((DEPTH, BRANCH_W), 0.05),
        'rw_k_a': gain((DEPTH, BRANCH_W)),
        'rw_r_k': nrm((DEPTH, RW_HEADS, RW_HD), 0.1),
        'rw_ln_g': gain((DEPTH, BRANCH_W)),
        'rw_ln_b': nrm((DEPTH, BRANCH_W), 0.02),
        'w_branch': nrm((DEPTH, N_BRANCH, BRANCH_W, D_MODEL), BRANCH_W ** -0.5),
        'w_out': nrm((DEPTH, D_MODEL, D_MODEL), D_MODEL ** -0.5),
        'norm_post_mix': gain((DEPTH, D_MODEL)),
        'norm_pre_ffn': gain((DEPTH, D_MODEL)),
        'w_ffn_gate': nrm((DEPTH, D_MODEL, D_FF), D_MODEL ** -0.5),
        'w_ffn_up': nrm((DEPTH, D_MODEL, D_FF), D_MODEL ** -0.5),
        'w_ffn_down': nrm((DEPTH, D_FF, D_MODEL), D_FF ** -0.5),
        'norm_post_ffn': gain((DEPTH, D_MODEL)),
        'w_ple': nrm((DEPTH, PLE_DIM, D_MODEL), PLE_DIM ** -0.5),
        'w_ple_gate': nrm((DEPTH, D_MODEL, D_MODEL), D_MODEL ** -0.5),
        'norm_ple': gain((DEPTH, D_MODEL)),
    }


def reference(x_prompt, x_sample, p_prompt, p_sample, state_conv_a, state_lru_a, state_hgrn, state_rwkv, state_shift_c,
              norm_pre_mix, w_in, conv_w, conv_b, lru_wa, lru_ba, lru_wx, lru_bx, lru_lambda, hg_lower_bounds, hg_norm_g,
              rw_mu, rw_w0, rw_w_up, rw_a0, rw_a_up, rw_g_up, rw_k_k, rw_k_a, rw_r_k, rw_ln_g, rw_ln_b,
              w_branch, w_out, norm_post_mix, norm_pre_ffn, w_ffn_gate, w_ffn_up, w_ffn_down, norm_post_ffn,
              w_ple, w_ple_gate, norm_ple):
    W = dict(norm_pre_mix=norm_pre_mix, w_in=w_in, conv_w=conv_w, conv_b=conv_b, lru_wa=lru_wa, lru_ba=lru_ba,
             lru_wx=lru_wx, lru_bx=lru_bx, lru_lambda=lru_lambda, hg_norm_g=hg_norm_g, rw_mu=rw_mu, rw_w0=rw_w0,
             rw_w_up=rw_w_up, rw_a0=rw_a0, rw_a_up=rw_a_up, rw_g_up=rw_g_up, rw_k_k=rw_k_k, rw_k_a=rw_k_a,
             rw_r_k=rw_r_k, rw_ln_g=rw_ln_g, rw_ln_b=rw_ln_b, w_branch=w_branch, w_out=w_out,
             norm_post_mix=norm_post_mix, norm_pre_ffn=norm_pre_ffn, w_ffn_gate=w_ffn_gate, w_ffn_up=w_ffn_up,
             w_ffn_down=w_ffn_down, norm_post_ffn=norm_post_ffn, w_ple=w_ple, w_ple_gate=w_ple_gate, norm_ple=norm_ple)
    sm = jax.nn.softmax(_f32(hg_lower_bounds), axis=0)
    lb_all = jnp.cumsum(sm, axis=0) - sm[0]
    dt = x_prompt.dtype
    bp = x_prompt.shape[0]
    zero_states = (jnp.zeros((DEPTH, bp, CONV_W - 1, LRU_W), dt), jnp.zeros((DEPTH, bp, LRU_W), dt),
                   jnp.zeros((DEPTH, bp, HG_HEADS, HG_DK, HG_DV), dt), jnp.zeros((DEPTH, bp, RW_HEADS, RW_HD, RW_HD), dt),
                   jnp.zeros((DEPTH, bp, RW_COLS), dt))
    pos_p = jnp.arange(x_prompt.shape[1])
    pos_s = PAST_LEN + jnp.arange(x_sample.shape[1])
    y_prompt, (conv_p, lru_p, hgrn_p, rwkv_p, shift_p) = run_trunk(x_prompt, p_prompt, zero_states, pos_p, lb_all, W)
    y_sample, (conv_s, lru_s, hgrn_s, rwkv_s, shift_s) = run_trunk(
        x_sample, p_sample, (state_conv_a, state_lru_a, state_hgrn, state_rwkv, state_shift_c), pos_s, lb_all, W)
    return (y_prompt, y_sample, conv_p, lru_p, hgrn_p, rwkv_p, shift_p, conv_s, lru_s, hgrn_s, rwkv_s, shift_s)
```

```cpp
#include <hip/hip_runtime.h>
#include <hip/hip_cooperative_groups.h>
#include <cstdio>
#include <cstdint>
namespace cg = cooperative_groups;

#define LAS __attribute__((address_space(3)))
typedef unsigned short bf16_t;
typedef short bf16x8 __attribute__((ext_vector_type(8)));
typedef float f32x4 __attribute__((ext_vector_type(4)));
typedef unsigned u32x2 __attribute__((ext_vector_type(2)));
typedef unsigned u32x4 __attribute__((ext_vector_type(4)));

constexpr int D = 1024, MP = 16384, MS = 512, M = MP + MS, SEQ = 2048, NB = 8, NSB = 128, SSEQ = 4;
constexpr int NPROJ = 4864, NGATE = 3072, INC = 7936, DFF = 2816, RWC = 1792, PLE = 256, NBR = 1536;
constexpr int C_XA = 0, C_GA = 512, C_BQ = 1024, C_BF = 1536, C_BI = 2048, C_BG = 2560, C_CB = 3072;
constexpr float EPS = 1e-6f;
constexpr size_t O_Y = 0, O_CONVP = (size_t)M * D, O_LRUP = O_CONVP + 2 * 8 * 3 * 512, O_HGP = O_LRUP + 2 * 8 * 512,
                 O_RWP = O_HGP + 2 * 8 * 4 * 128 * 128, O_SHP = O_RWP + 2 * 8 * 8 * 64 * 64, O_CONVS = O_SHP + 2 * 8 * 1792,
                 O_LRUS = O_CONVS + 2 * 128 * 3 * 512, O_HGS = O_LRUS + 2 * 128 * 512, O_RWS = O_HGS + (size_t)2 * 128 * 4 * 128 * 128,
                 O_SHS = O_RWS + (size_t)2 * 128 * 8 * 64 * 64, O_END = O_SHS + 2 * 128 * 1792;
constexpr size_t MiB = 1u << 20;
constexpr size_t WS_CTL = 0;
constexpr size_t WS_W = 1 * MiB;
constexpr size_t W_IN = 0, W_BR = W_IN + (size_t)INC * D * 2, W_OUT = W_BR + (size_t)3072 * 512 * 2, W_GU = W_OUT + (size_t)D * D * 2,
                 W_DN = W_GU + (size_t)2 * DFF * D * 2, W_PLE = W_DN + (size_t)D * DFF * 2, W_PG = W_PLE + (size_t)D * PLE * 2,
                 W_WUP = W_PG + (size_t)D * D * 2, W_AUP = W_WUP + 512 * 64 * 2, W_GUP = W_AUP + 512 * 64 * 2, W_LWA = W_GUP + 512 * 128 * 2,
                 W_LWX = W_LWA + 8 * 64 * 64 * 2, W_END = W_LWX + 8 * 64 * 64 * 2;
constexpr size_t WS_XN = WS_W + 42 * MiB;
constexpr size_t WS_PROJ = WS_XN + (size_t)M * D * 2;
constexpr size_t WS_BR = WS_PROJ + (size_t)M * NPROJ * 2;
constexpr size_t WS_PB = WS_BR + (size_t)M * NBR * 2;
constexpr size_t WS_WEXP = WS_PB + (size_t)M * PLE * 2;
constexpr size_t WS_BON = WS_WEXP + (size_t)M * 512 * 2;
constexpr size_t WS_GG = WS_BON + (size_t)M * 512 * 2;
constexpr size_t WS_AV = WS_GG + (size_t)M * 512 * 2;
constexpr size_t WS_INV = WS_AV + (size_t)M * 512 * 2;
constexpr size_t WS_RKR = WS_INV + (size_t)M * 8 * 4;
constexpr size_t WS_HQS = WS_RKR + (size_t)M * 8 * 4;
constexpr size_t WS_HO1 = WS_HQS + (size_t)1024 * 64 * 128 * 2;
constexpr size_t WS_HKV = WS_HO1 + (size_t)1024 * 64 * 128 * 4;
constexpr size_t WS_HEB = WS_HKV + (size_t)1024 * 128 * 128 * 2;
constexpr size_t WS_HGG = WS_HEB + (size_t)1024 * 128 * 4;
constexpr size_t WS_LLA = WS_HGG + (size_t)MP * 512 * 2;
constexpr size_t WS_G2 = WS_LLA + (size_t)MP * 512 * 2;
constexpr size_t WS_END = WS_G2 + (size_t)M * NGATE * 2;
static_assert(WS_END <= ((size_t)608 << 20), "workspace budget");
static_assert(W_END <= 42 * MiB, "weights region");
constexpr size_t OV_G = 0;
constexpr size_t OV_S = (size_t)M * NGATE * 2;
constexpr size_t OV_MIX = 0;
constexpr size_t OV_HID = (size_t)M * D * 2;
static_assert(OV_S + (size_t)M * D * 2 <= (size_t)M * NPROJ * 2 && OV_HID + (size_t)M * DFF * 2 <= (size_t)M * NPROJ * 2, "overlay");

constexpr int LDS_BYTES = 147456;

__device__ __forceinline__ unsigned f2bf(float f) { unsigned u = __builtin_bit_cast(unsigned, f); return (u + 0x7fffu + ((u >> 16) & 1u)) >> 16; }
__device__ __forceinline__ float bf2f(unsigned h) { return __builtin_bit_cast(float, h << 16); }
typedef float f32x2_t __attribute__((ext_vector_type(2)));
typedef __bf16 bf16x2_t __attribute__((ext_vector_type(2)));
__device__ __forceinline__ unsigned pk2(float lo, float hi) { const f32x2_t v = {lo, hi}; const bf16x2_t b = __builtin_convertvector(v, bf16x2_t); return __builtin_bit_cast(unsigned, b); }
__device__ __forceinline__ float sigmoidf_(float x) { return __builtin_amdgcn_rcpf(1.f + __expf(-x)); }
__device__ __forceinline__ float siluf_(float x) { return x * __builtin_amdgcn_rcpf(1.f + __expf(-x)); }
__device__ __forceinline__ float softplusf_(float x) { return fmaxf(x, 0.f) + log1pf(__expf(-fabsf(x))); }
__device__ __forceinline__ float gelu_tanh(float x) { const float u = 0.7978845608028654f * (x + 0.044715f * x * x * x); return x * sigmoidf_(2.f * u); }
__device__ __forceinline__ float tanh_fast(float x) { return 2.f * sigmoidf_(2.f * x) - 1.f; }
__device__ __forceinline__ float wave_sum(float v) {
#pragma unroll
    for (int o = 1; o < 64; o <<= 1) v += __shfl_xor(v, o);
    return v;
}
#define DPP_ADD(v, ctrl) ((v) + __builtin_bit_cast(float, __builtin_amdgcn_update_dpp(0, __builtin_bit_cast(int, (v)), (ctrl), 0xf, 0xf, false)))
__device__ __forceinline__ float row16_sum(float v) {
    v = DPP_ADD(v, 0xB1); v = DPP_ADD(v, 0x4E); v = DPP_ADD(v, 0x141); v = DPP_ADD(v, 0x140); return v;
}
__device__ __forceinline__ float wave_sum_l63(float v) {
    v = row16_sum(v);
    v += __builtin_bit_cast(float, __builtin_amdgcn_update_dpp(0, __builtin_bit_cast(int, v), 0x142, 0xa, 0xf, false));
    v += __builtin_bit_cast(float, __builtin_amdgcn_update_dpp(0, __builtin_bit_cast(int, v), 0x143, 0xc, 0xf, false));
    return v;
}
__device__ __forceinline__ float wave_sum_all(float v) {
    v = row16_sum(v); v += __shfl_xor(v, 16); v += __shfl_xor(v, 32); return v;
}
#define LDS_WAIT() asm volatile("s_waitcnt lgkmcnt(0)" ::: "memory")

namespace pg8 {
enum { EP_STORE = 0, EP_SIGMOID = 1, EP_MULINPLACE = 2, EP_GLU = 3, EP_GATEACC = 4 };
constexpr int BM = 256, BK = 64, HALF = 128, HTB = HALF * BK * 2, STAGE_BYTES = 8 * HTB, NXCD = 8, WGM = 8;
__host__ __device__ __forceinline__ int lds_byte(int r, int c) { const int st = (r >> 4) * 2 + (c >> 5), rr = r & 15, cc = c & 31, ob = rr * 64 + cc * 2; return st * 1024 + (ob ^ (((ob >> 9) & 1) << 5)); }
__host__ __device__ __forceinline__ void stage_rc(int b, int& R, int& C) { const int st = b / 1024, sb = b % 1024, swz = sb ^ (((sb >> 9) & 1) << 5); R = (st >> 1) * 16 + swz / 64; C = (st & 1) * 32 + (swz % 64) / 2; }
__host__ __device__ __forceinline__ int perm32(int rho) { const int n = rho >> 4, i = rho & 15; return 8 * (i >> 2) + 4 * n + (i & 3); }
struct Unit { int pm, pn, ak; };
struct Gemm { const bf16_t* A; const bf16_t* Bt; int K, lda, ldb; };
struct StaticOrder {
    int nM, nN, nwg, G, c;
    __device__ void init(int M_, int N_, int G_, int c_) { nM = M_ / BM; nN = N_ / BM; nwg = nM * nN; G = G_; c = c_; }
    __device__ bool next(int i, Unit& u) const {
        const long L = (long)i * G + c; if (L >= nwg) return false;
        int wgid = (int)L; { const int q = nwg / NXCD, r = nwg % NXCD, xcd = wgid % NXCD, off = wgid / NXCD; wgid = (xcd < r ? xcd * (q + 1) : r * (q + 1) + (xcd - r) * q) + off; }
        const int nig = WGM * nN, gid = wgid / nig, fm = gid * WGM, gsz = (nM - fm) < WGM ? (nM - fm) : WGM;
        u.pm = fm + ((wgid % nig) % gsz); u.pn = (wgid % nig) / gsz; u.ak = 0; return true;
    }
};
struct Order {
    StaticOrder b; int three;
    __device__ void init(int M_, int N_, int G_, int c_, int three_) { b.init(M_, N_, G_, c_); three = three_; }
    __device__ bool next(int i, Unit& u) const {
        if (!three) return b.next(i, u);
        Unit t; if (!b.next(i / 3, t)) return false; const int n = i % 3;
        u.pm = t.pm; u.pn = n * 4 + t.pn; u.ak = n * 512; return true;
    }
};

template <class Epi, class Sched>
__device__ __forceinline__ void gemm_phase(LAS unsigned char* lds, int wid, const Gemm g, const Sched& S, const Epi& E) {
    int lane_ = (int)__builtin_amdgcn_mbcnt_hi(~0u, __builtin_amdgcn_mbcnt_lo(~0u, 0u)); asm volatile("" : "+v"(lane_));
    const int lane = lane_, tid = wid * 64 + lane, wr = wid >> 2, wc = wid & 3, fr = lane & 15, fq = lane >> 4;
    const int K = g.K, nt = K / BK;
    unsigned voffA[2], voffB[2];
#pragma unroll
    for (int i = 0; i < 2; ++i) { int R, C; stage_rc(tid * 16 + i * 8192, R, C); const int Rb = (E.mode != EP_GLU) ? ((R & ~31) + perm32(R & 31)) : R;
        voffA[i] = (unsigned)(R * g.lda + C) * 2u; voffB[i] = (unsigned)(Rb * g.ldb + C) * 2u; }
    const size_t kstep = (size_t)(BK * 2);
    const size_t hstepA = (size_t)HALF * g.lda * 2, hstepB = (size_t)HALF * g.ldb * 2;
    const size_t tstepA = 2 * hstepA, tstepB = 2 * hstepB;
    const unsigned ldsw = (unsigned)wid * 1024u;
    const int aoff = lds_byte(wr * 64 + fr, fq * 8), boff = lds_byte(wc * 32 + fr, fq * 8);
#define PG8_SA(b, h) (((b) * 2 + (h)) * HTB)
#define PG8_SB(b, h) ((4 + (b) * 2 + (h)) * HTB)
#define PG8_STAGE(bufoff, gbase, voff) do { _Pragma("unroll") for (int _i = 0; _i < 2; ++_i) \
        __builtin_amdgcn_global_load_lds((const unsigned*)((const char*)(gbase) + (voff)[_i]), (LAS unsigned*)(lds + (bufoff) + ldsw + _i * 8192), 16, 0, 0); } while (0)
#define PG8_LDA(dst, b, h) do { _Pragma("unroll") for (int m = 0; m < 4; ++m) _Pragma("unroll") for (int k = 0; k < 2; ++k) dst[m][k] = *(const LAS bf16x8*)(lds + PG8_SA(b, h) + aoff + m * 2048 + k * 1024); } while (0)
#define PG8_LDB(dst, b, h) do { _Pragma("unroll") for (int n = 0; n < 2; ++n) _Pragma("unroll") for (int k = 0; k < 2; ++k) dst[n][k] = *(const LAS bf16x8*)(lds + PG8_SB(b, h) + boff + n * 2048 + k * 1024); } while (0)
#define PG8_MMA(ai, bj, At, Bt) do { __builtin_amdgcn_s_setprio(1); _Pragma("unroll") for (int m = 0; m < 4; ++m) _Pragma("unroll") for (int n = 0; n < 2; ++n) _Pragma("unroll") for (int k = 0; k < 2; ++k) \
        acc[ai][bj][m][n] = __builtin_amdgcn_mfma_f32_16x16x32_bf16(Bt[n][k], At[m][k], acc[ai][bj][m][n], 0, 0, 0); __builtin_amdgcn_s_setprio(0); } while (0)
#define PG8_WAIT_V(n) asm volatile("s_waitcnt vmcnt(" #n ")" ::: "memory")
#define PG8_WAIT_L(n) asm volatile("s_waitcnt lgkmcnt(" #n ")" ::: "memory")
#define PG8_BAR __builtin_amdgcn_s_barrier()
#define PG8_SCHED __builtin_amdgcn_sched_barrier(0)
    Unit cur, nxt; int ui = 0;
    if (!S.next(0, cur)) return;
    f32x4 acc[2][2][4][2];
#pragma unroll
    for (int a = 0; a < 2; ++a)
#pragma unroll
        for (int b = 0; b < 2; ++b)
#pragma unroll
            for (int m = 0; m < 4; ++m)
#pragma unroll
                for (int n = 0; n < 2; ++n) acc[a][b][m][n] = (f32x4){0.f, 0.f, 0.f, 0.f};
    bf16x8 At[4][2], B0[2][2], B1[2][2];
    const char* cA = (const char*)g.A + (size_t)cur.pm * tstepA + (size_t)cur.ak * 2; const char* cB = (const char*)g.Bt + (size_t)cur.pn * tstepB;
    PG8_STAGE(PG8_SB(0, 0), cB, voffB); PG8_STAGE(PG8_SB(0, 1), cB + hstepB, voffB); PG8_STAGE(PG8_SA(0, 0), cA, voffA); PG8_STAGE(PG8_SA(0, 1), cA + hstepA, voffA);
    if (wr == 1) PG8_BAR;
    PG8_WAIT_V(2); PG8_BAR;
    PG8_STAGE(PG8_SB(1, 0), cB + kstep, voffB); PG8_STAGE(PG8_SA(1, 0), cA + kstep, voffA); PG8_STAGE(PG8_SB(1, 1), cB + hstepB + kstep, voffB);
    PG8_WAIT_V(6); PG8_BAR;
    for (;;) {
        const bool has_next = S.next(ui + 1, nxt);
        const char* nA = has_next ? (const char*)g.A + (size_t)nxt.pm * tstepA + (size_t)nxt.ak * 2 : cA; const char* nB = has_next ? (const char*)g.Bt + (size_t)nxt.pn * tstepB : cB;
        for (int t = 0; t < nt; t += 2) {
            const bool last = (t == nt - 2);
            const char* a1 = cA + (size_t)(t + 1) * kstep;
            const char* a2 = last ? nA : cA + (size_t)(t + 2) * kstep; const char* b2 = last ? nB : cB + (size_t)(t + 2) * kstep;
            const char* a3 = a2 + kstep; const char* b3 = b2 + kstep;
            PG8_LDB(B0, 0, 0); PG8_LDB(B1, 0, 1); PG8_SCHED; PG8_LDA(At, 0, 0); PG8_STAGE(PG8_SA(1, 1), a1 + hstepA, voffA);
            PG8_WAIT_V(8); PG8_WAIT_L(0); PG8_BAR; PG8_MMA(0, 0, At, B0); PG8_MMA(0, 1, At, B1); PG8_BAR; PG8_SCHED;
            PG8_LDA(At, 0, 1); PG8_STAGE(PG8_SB(0, 0), b2, voffB); PG8_STAGE(PG8_SB(0, 1), b2 + hstepB, voffB); PG8_STAGE(PG8_SA(0, 0), a2, voffA);
            PG8_WAIT_V(8); PG8_WAIT_L(0); PG8_BAR; PG8_MMA(1, 0, At, B0); PG8_MMA(1, 1, At, B1); PG8_BAR; PG8_SCHED;
            PG8_LDB(B0, 1, 0); PG8_LDB(B1, 1, 1); PG8_SCHED; PG8_LDA(At, 1, 0); PG8_STAGE(PG8_SA(0, 1), a2 + hstepA, voffA);
            PG8_WAIT_V(8); PG8_WAIT_L(0); PG8_BAR; PG8_MMA(0, 0, At, B0); PG8_MMA(0, 1, At, B1); PG8_BAR; PG8_SCHED;
            PG8_LDA(At, 1, 1); PG8_STAGE(PG8_SB(1, 0), b3, voffB); PG8_STAGE(PG8_SB(1, 1), b3 + hstepB, voffB); PG8_STAGE(PG8_SA(1, 0), a3, voffA);
            PG8_WAIT_V(8); PG8_WAIT_L(0); PG8_BAR; PG8_MMA(1, 0, At, B0); PG8_MMA(1, 1, At, B1); PG8_BAR; PG8_SCHED;
        }
        if (wr == 0) PG8_BAR;
        E(acc, cur, wr, wc, fr, fq);
        if (!has_next) break;
#pragma unroll
        for (int a = 0; a < 2; ++a)
#pragma unroll
            for (int b = 0; b < 2; ++b)
#pragma unroll
                for (int m = 0; m < 4; ++m)
#pragma unroll
                    for (int n = 0; n < 2; ++n) acc[a][b][m][n] = (f32x4){0.f, 0.f, 0.f, 0.f};
        cur = nxt; cA = nA; cB = nB; ++ui;
        if (wr == 1) PG8_BAR;
    }
    PG8_WAIT_V(0);
    PG8_BAR;
#undef PG8_SA
#undef PG8_SB
#undef PG8_STAGE
#undef PG8_LDA
#undef PG8_LDB
#undef PG8_MMA
#undef PG8_WAIT_V
#undef PG8_WAIT_L
#undef PG8_BAR
#undef PG8_SCHED
}

__device__ __forceinline__ void st4(bf16_t* p, f32x4 v) { u32x2 w; w.x = pk2(v[0], v[1]); w.y = pk2(v[2], v[3]); *(u32x2*)p = w; }
__device__ __forceinline__ f32x4 ld4(const bf16_t* p) { const u32x2 w = *(const u32x2*)p; return (f32x4){bf2f(w.x & 0xffffu), bf2f(w.x >> 16), bf2f(w.y & 0xffffu), bf2f(w.y >> 16)}; }
__device__ __forceinline__ void st8(bf16_t* p, f32x4 a, f32x4 b) { u32x4 w; w.x = pk2(a[0], a[1]); w.y = pk2(a[2], a[3]); w.z = pk2(b[0], b[1]); w.w = pk2(b[2], b[3]); *(u32x4*)p = w; }
__device__ __forceinline__ void ld8(const bf16_t* p, f32x4& a, f32x4& b) { const u32x4 w = *(const u32x4*)p; a = (f32x4){bf2f(w.x & 0xffffu), bf2f(w.x >> 16), bf2f(w.y & 0xffffu), bf2f(w.y >> 16)}; b = (f32x4){bf2f(w.z & 0xffffu), bf2f(w.z >> 16), bf2f(w.w & 0xffffu), bf2f(w.w >> 16)}; }
struct Epi {
    int mode; bf16_t* O; int ldc; const bf16_t* G; int ldg;
    __device__ __forceinline__ void operator()(const f32x4 (&acc)[2][2][4][2], const Unit& u, int wr, int wc, int fr, int fq) const {
        const int row0 = u.pm * BM + wr * 64 + fr;
        if (mode == EP_GLU) {
#pragma unroll
            for (int ai = 0; ai < 2; ++ai)
#pragma unroll
                for (int m = 0; m < 4; ++m) {
                    bf16_t* rp = O + (size_t)(row0 + ai * HALF + m * 16) * ldc + u.pn * 128 + wc * 16 + 4 * fq;
#pragma unroll
                    for (int bj = 0; bj < 2; ++bj) {
                        const f32x4 gt = acc[ai][bj][m][0], up = acc[ai][bj][m][1]; f32x4 v;
#pragma unroll
                        for (int j = 0; j < 4; ++j) v[j] = siluf_(gt[j]) * up[j];
                        st4(rp + bj * 64, v);
                    }
                }
        } else if (mode == EP_GATEACC) {
            const int nb = u.pn >> 2, colb = (u.pn & 3) * BM + wc * 32 + 8 * fq;
#pragma unroll
            for (int ai = 0; ai < 2; ++ai)
#pragma unroll
                for (int m = 0; m < 4; ++m) {
                    const size_t row = (size_t)(row0 + ai * HALF + m * 16);
                    bf16_t* rp = O + row * ldc + colb; const bf16_t* gp = G + row * ldg + nb * 1024 + colb;
#pragma unroll
                    for (int bj = 0; bj < 2; ++bj) {
                        f32x4 g0, g1; ld8(gp + bj * HALF, g0, g1);
                        f32x4 v0 = acc[ai][bj][m][0] * g0, v1 = acc[ai][bj][m][1] * g1;
                        if (nb > 0) { f32x4 p0, p1; ld8(rp + bj * HALF, p0, p1); v0 = v0 + p0; v1 = v1 + p1; }
                        st8(rp + bj * HALF, v0, v1);
                    }
                }
        } else {
#pragma unroll
            for (int ai = 0; ai < 2; ++ai)
#pragma unroll
                for (int m = 0; m < 4; ++m) {
                    bf16_t* rp = O + (size_t)(row0 + ai * HALF + m * 16) * ldc + u.pn * BM + wc * 32 + 8 * fq;
#pragma unroll
                    for (int bj = 0; bj < 2; ++bj) {
                        f32x4 v0 = acc[ai][bj][m][0], v1 = acc[ai][bj][m][1];
                        if (mode == EP_SIGMOID) {
#pragma unroll
                            for (int j = 0; j < 4; ++j) { v0[j] = sigmoidf_(v0[j]); v1[j] = sigmoidf_(v1[j]); }
                        }
                        if (mode == EP_MULINPLACE) { f32x4 p0, p1; ld8(rp + bj * HALF, p0, p1); v0 = v0 * p0; v1 = v1 * p1; }
                        st8(rp + bj * HALF, v0, v1);
                    }
                }
        }
    }
};
}

struct Args { const float* in[42]; float* out; unsigned char* ws; };
typedef const __attribute__((address_space(4))) Args* CArgs;
__device__ __forceinline__ CArgs get_args() { CArgs p = (CArgs)__builtin_amdgcn_kernarg_segment_ptr(); asm volatile("" : "+s"(p)); return p; }

struct Ctx {
    LAS unsigned char* lds; int tid, lane, wave, G, bid;
};
__device__ __forceinline__ Ctx fresh(const Ctx& F0) { Ctx F = F0; int t = (int)__builtin_amdgcn_mbcnt_hi(~0u, __builtin_amdgcn_mbcnt_lo(~0u, 0u)); asm volatile("" : "+v"(t)); F.lane = t; F.tid = F0.wave * 64 + t; return F; }

__device__ __forceinline__ void tr_item(const float* W, int K, int N, bf16_t* WT, int row_off, const float* gain, int rmap, LAS float* scr, int item, int lane) {
    const int nblk = N / 32, kb = item / nblk, nb = item % nblk, k0 = 64 * kb, n0 = 32 * nb;
#pragma unroll 8
    for (int i = 0; i < 32; ++i) { const int kk = 2 * i + (lane >> 5); const float gsc = gain ? gain[k0 + kk] : 1.f; scr[kk * 33 + (lane & 31)] = W[(size_t)(k0 + kk) * N + n0 + (lane & 31)] * gsc; }
    LDS_WAIT(); asm volatile("" ::: "memory");
    const int c = lane & 7;
#pragma unroll
    for (int j = 0; j < 4; ++j) { const int n = (lane >> 3) + 8 * j; const LAS float* s = scr + (8 * c) * 33 + n;
        u32x4 o; o.x = pk2(s[0 * 33], s[1 * 33]); o.y = pk2(s[2 * 33], s[3 * 33]); o.z = pk2(s[4 * 33], s[5 * 33]); o.w = pk2(s[6 * 33], s[7 * 33]);
        const int ng = n0 + n; const int orow = rmap == 0 ? row_off + ng : (32 * (ng >> 4) + (ng & 15) + (rmap == 2 ? 16 : 0));
        *(u32x4*)(WT + (size_t)orow * K + k0 + 8 * c) = o; }
    LDS_WAIT(); asm volatile("" ::: "memory");
}

__device__ __forceinline__ void convert_weights(const Ctx& F0, int l) {
    const Ctx F = fresh(F0);
    CArgs a = get_args(); unsigned char* wb = a->ws + WS_W;
    LAS float* scr = (LAS float*)(F.lds + F.wave * 16384);
    const int gw = F.bid * 8 + F.wave, NGW = F.G * 8;
    constexpr int I_IN = 16 * (INC / 32), I_BR = 8 * 32, I_OUT = 16 * 32, I_G = 16 * (DFF / 32), I_DN = (DFF / 64) * 32, I_PLE = 4 * 32, I_PG = 16 * 32, I_UP = 16, I_GUP = 32, I_L = 2;
    constexpr int NIT = I_IN + 3 * I_BR + I_OUT + 2 * I_G + I_DN + I_PLE + I_PG + 2 * I_UP + I_GUP + 16 * I_L;
    for (int it = gw; it < NIT; it += NGW) {
        int r = it; const float* W; int K, N, row_off = 0, rmap = 0, widx; size_t woff, wtoff; const float* gain = nullptr;
        if (r < I_IN) { widx = 10; woff = (size_t)l * D * INC; K = D; N = INC; wtoff = W_IN; gain = a->in[9] + l * D; }
        else if ((r -= I_IN) < 3 * I_BR) { const int n = r / I_BR; r %= I_BR; widx = 31; woff = ((size_t)l * 3 + n) * 512 * D; K = 512; N = D; wtoff = W_BR; row_off = n * 1024; }
        else if ((r -= 3 * I_BR) < I_OUT) { widx = 32; woff = (size_t)l * D * D; K = D; N = D; wtoff = W_OUT; }
        else if ((r -= I_OUT) < I_G) { widx = 35; woff = (size_t)l * D * DFF; K = D; N = DFF; wtoff = W_GU; gain = a->in[34] + l * D; rmap = 1; }
        else if ((r -= I_G) < I_G) { widx = 36; woff = (size_t)l * D * DFF; K = D; N = DFF; wtoff = W_GU; gain = a->in[34] + l * D; rmap = 2; }
        else if ((r -= I_G) < I_DN) { widx = 37; woff = (size_t)l * DFF * D; K = DFF; N = D; wtoff = W_DN; }
        else if ((r -= I_DN) < I_PLE) { widx = 39; woff = (size_t)l * PLE * D; K = PLE; N = D; wtoff = W_PLE; }
        else if ((r -= I_PLE) < I_PG) { widx = 40; woff = (size_t)l * D * D; K = D; N = D; wtoff = W_PG; }
        else if ((r -= I_PG) < I_UP) { widx = 22; woff = (size_t)l * 64 * 512; K = 64; N = 512; wtoff = W_WUP; }
        else if ((r -= I_UP) < I_UP) { widx = 24; woff = (size_t)l * 64 * 512; K = 64; N = 512; wtoff = W_AUP; }
        else if ((r -= I_UP) < I_GUP) { widx = 25; woff = (size_t)l * 128 * 512; K = 128; N = 512; wtoff = W_GUP; }
        else if ((r -= I_GUP) < 8 * I_L) { const int blk = r / I_L; r %= I_L; widx = 13; woff = ((size_t)l * 8 + blk) * 4096; K = 64; N = 64; wtoff = W_LWA + (size_t)blk * 8192; }
        else { r -= 8 * I_L; const int blk = r / I_L; r %= I_L; widx = 15; woff = ((size_t)l * 8 + blk) * 4096; K = 64; N = 64; wtoff = W_LWX + (size_t)blk * 8192; }
        W = a->in[widx] + woff;
        tr_item(W, K, N, (bf16_t*)(wb + wtoff), row_off, gain, rmap, scr, r, F.lane);
    }
}

__device__ __forceinline__ void row_pass(const Ctx& F0, int mode, int l, const bf16_t* Y, const float* gpost) {
    const Ctx F = fresh(F0);
    CArgs a = get_args();
    float* X = a->out; bf16_t* XN = (bf16_t*)(a->ws + WS_XN);
    const int gw = F.bid * 8 + F.wave, NGW = F.G * 8, lane = F.lane;
    for (int m = gw; m < M; m += NGW) {
        f32x4 v[4];
        if (mode == 0) {
            const float* xr = (m < MP) ? a->in[0] + (size_t)m * D : a->in[1] + (size_t)(m - MP) * D;
#pragma unroll
            for (int j = 0; j < 4; ++j) v[j] = *(const f32x4*)(xr + j * 256 + lane * 4);
        } else {
            f32x4 y[4]; float s = 0.f;
#pragma unroll
            for (int j = 0; j < 4; ++j) { y[j] = pg8::ld4(Y + (size_t)m * D + j * 256 + lane * 4); s += y[j][0] * y[j][0] + y[j][1] * y[j][1] + y[j][2] * y[j][2] + y[j][3] * y[j][3]; }
            const float rs = rsqrtf(wave_sum(s) * (1.f / D) + EPS);
#pragma unroll
            for (int j = 0; j < 4; ++j) { const f32x4 gq = *(const f32x4*)(gpost + j * 256 + lane * 4); const f32x4 xv = *(const f32x4*)(X + (size_t)m * D + j * 256 + lane * 4); v[j] = xv + y[j] * rs * gq; }
        }
        float s2 = 0.f;
#pragma unroll
        for (int j = 0; j < 4; ++j) s2 += v[j][0] * v[j][0] + v[j][1] * v[j][1] + v[j][2] * v[j][2] + v[j][3] * v[j][3];
        const float r2 = (mode == 2) ? 1.f : rsqrtf(wave_sum(s2) * (1.f / D) + EPS);
#pragma unroll
        for (int j = 0; j < 4; ++j) { *(f32x4*)(X + (size_t)m * D + j * 256 + lane * 4) = v[j]; pg8::st4(XN + (size_t)m * D + j * 256 + lane * 4, v[j] * r2); }
        if (mode == 2) {
            const float* pr = (m < MP) ? a->in[2] + ((size_t)l * MP + m) * PLE : a->in[3] + ((size_t)l * MS + (m - MP)) * PLE;
            const f32x4 pv = *(const f32x4*)(pr + lane * 4);
            pg8::st4((bf16_t*)(a->ws + WS_PB) + (size_t)m * PLE + lane * 4, pv);
        }
    }
}

__device__ __forceinline__ void rw_finish(const Ctx& F0, int l) {
    const Ctx F = fresh(F0);
    CArgs a = get_args();
    const bf16_t* BO = (const bf16_t*)(a->ws + WS_BON); const bf16_t* GGp = (const bf16_t*)(a->ws + WS_GG);
    bf16_t* BR = (bf16_t*)(a->ws + WS_BR);
    const float* lng = a->in[29] + l * 512; const float* lnb = a->in[30] + l * 512;
    const int gw = F.bid * 8 + F.wave, NGW = F.G * 8, lane = F.lane;
    for (int it0 = gw * 4; it0 < M * 8; it0 += NGW * 4) {
        float o[4], bo[4], gg[4]; bf16_t* op[4];
#pragma unroll
        for (int q = 0; q < 4; ++q) { const int it = it0 + q, m = it >> 3, h = it & 7; const size_t idx = (size_t)m * 512 + h * 64 + lane; op[q] = BR + (size_t)m * NBR + 1024 + h * 64 + lane;
            o[q] = bf2f(*op[q]); bo[q] = bf2f(BO[idx]); gg[q] = bf2f(GGp[idx]); }
#pragma unroll
        for (int q = 0; q < 4; ++q) { const int h = (it0 + q) & 7;
            const float mean = wave_sum_all(o[q]) * (1.f / 64.f); const float dlt = o[q] - mean;
            const float var = wave_sum_all(dlt * dlt) * (1.f / 64.f);
            const float y = (dlt * rsqrtf(var + 64e-5f) * lng[h * 64 + lane] + lnb[h * 64 + lane] + bo[q]) * gg[q];
            *op[q] = (bf16_t)f2bf(y); }
    }
}

__device__ __forceinline__ void st4l(LAS bf16_t* p, f32x4 v) { u32x2 w; w.x = pk2(v[0], v[1]); w.y = pk2(v[2], v[3]); *(LAS u32x2*)p = w; }

__device__ __forceinline__ void rw_prepass(const Ctx& F0, int l) {
    const Ctx F = fresh(F0);
    CArgs a = get_args(); const int tid = F.tid, lane = F.lane, wave = F.wave, fr = lane & 15, fq = lane >> 4, h = wave;
    const bf16_t* PROJ = (const bf16_t*)(a->ws + WS_PROJ);
    bf16_t* WEXP = (bf16_t*)(a->ws + WS_WEXP); bf16_t* AVp = (bf16_t*)(a->ws + WS_AV); bf16_t* GGp = (bf16_t*)(a->ws + WS_GG);
    float* INV = (float*)(a->ws + WS_INV); float* RKR = (float*)(a->ws + WS_RKR);
    LAS bf16_t* ATANH = (LAS bf16_t*)F.lds;
    LAS bf16_t* AAL = ATANH + 32 * 72;
    LAS bf16_t* ASG = AAL + 32 * 72;
    LAS float* ALDS = (LAS float*)(ASG + 32 * 136) + wave * 2048;
    const float* mu = a->in[20] + l * RWC; const float* shs = a->in[8] + (size_t)l * NSB * RWC;
    const int ch = l * 512 + h * 64 + lane;
    const float c_kk = a->in[26][ch], c_ka = a->in[27][ch], c_rk = a->in[28][ch], mu_r = mu[h * 64 + lane], mu_k = mu[512 + h * 64 + lane];
    const bf16_t* wupT = (const bf16_t*)(a->ws + WS_W + W_WUP); const bf16_t* aupT = (const bf16_t*)(a->ws + WS_W + W_AUP); const bf16_t* gupT = (const bf16_t*)(a->ws + WS_W + W_GUP);
    for (int u = F.bid; u < M / 32; u += F.G) {
        const int m0 = u * 32;
        unsigned rkraw[16], rkraw2[16];
        { const bf16_t* prq = PROJ + (size_t)m0 * NPROJ + C_CB + h * 64 + lane;
#pragma unroll
          for (int t = 0; t < 16; ++t) rkraw[t] = (unsigned)prq[(size_t)t * NPROJ] | ((unsigned)prq[(size_t)t * NPROJ + 512] << 16); }
        __syncthreads();
        {
            const int tok = tid >> 4, c0 = (tid & 15) * 16, m = m0 + tok;
            const bf16_t* pc = PROJ + (size_t)m * NPROJ + C_CB + 1536 + c0;
            const bool first = (m < MP) ? ((m & (SEQ - 1)) == 0) : (((m - MP) & 3) == 0);
#pragma unroll
            for (int i = 0; i < 4; ++i) {
                const f32x4 cur = pg8::ld4(pc + i * 4); f32x4 prev;
                if (!first) prev = pg8::ld4(pc - NPROJ + i * 4);
                else if (m >= MP) prev = *(const f32x4*)(shs + (size_t)((m - MP) >> 2) * RWC + 1536 + c0 + i * 4);
                else prev = (f32x4){0.f, 0.f, 0.f, 0.f};
                const f32x4 mq = *(const f32x4*)(mu + 1536 + c0 + i * 4);
                f32x4 xm = cur + (prev - cur) * mq;
                const int cc = c0 + i * 4;
                if (cc < 64) {
#pragma unroll
                    for (int j = 0; j < 4; ++j) xm[j] = tanh_fast(xm[j]);
                    st4l(ATANH + tok * 72 + cc, xm);
                } else if (cc < 128) st4l(AAL + tok * 72 + cc - 64, xm);
                else {
#pragma unroll
                    for (int j = 0; j < 4; ++j) xm[j] = sigmoidf_(xm[j]);
                    st4l(ASG + tok * 136 + cc - 128, xm);
                }
            }
        }
        __syncthreads();
#define RWP_LOADF(X, nt_) do { const int col_ = h * 64 + (nt_) * 16 + fr; \
            X##w0 = *(const bf16x8*)(wupT + (size_t)col_ * 64 + fq * 8); X##w1 = *(const bf16x8*)(wupT + (size_t)col_ * 64 + 32 + fq * 8); \
            X##a0 = *(const bf16x8*)(aupT + (size_t)col_ * 64 + fq * 8); X##a1 = *(const bf16x8*)(aupT + (size_t)col_ * 64 + 32 + fq * 8); \
            _Pragma("unroll") for (int ks = 0; ks < 4; ++ks) X##g[ks] = *(const bf16x8*)(gupT + (size_t)col_ * 128 + ks * 32 + fq * 8); \
            X##c0 = a->in[21][l * 512 + col_]; X##c1 = a->in[23][l * 512 + col_]; } while (0)
        bf16x8 Nw0, Nw1, Na0, Na1, Ng[4]; float Nc0, Nc1;
        RWP_LOADF(N, 0);
#pragma unroll
        for (int nt = 0; nt < 4; ++nt) {
            const int col = h * 64 + nt * 16 + fr;
            const bf16x8 bw0 = Nw0, bw1 = Nw1, ba0 = Na0, ba1 = Na1; bf16x8 bg[4];
#pragma unroll
            for (int ks = 0; ks < 4; ++ks) bg[ks] = Ng[ks];
            const float w0 = Nc0, a0 = Nc1;
            if (nt < 3) RWP_LOADF(N, nt + 1);
#pragma unroll
            for (int mt = 0; mt < 2; ++mt) {
                f32x4 cw = (f32x4){0.f, 0.f, 0.f, 0.f}, ca = cw, cgv = cw;
                const LAS bf16_t* At = ATANH + (mt * 16 + fr) * 72 + fq * 8; const LAS bf16_t* Aa = AAL + (mt * 16 + fr) * 72 + fq * 8; const LAS bf16_t* Ag = ASG + (mt * 16 + fr) * 136 + fq * 8;
                cw = __builtin_amdgcn_mfma_f32_16x16x32_bf16(*(const LAS bf16x8*)(At), bw0, cw, 0, 0, 0);
                cw = __builtin_amdgcn_mfma_f32_16x16x32_bf16(*(const LAS bf16x8*)(At + 32), bw1, cw, 0, 0, 0);
                ca = __builtin_amdgcn_mfma_f32_16x16x32_bf16(*(const LAS bf16x8*)(Aa), ba0, ca, 0, 0, 0);
                ca = __builtin_amdgcn_mfma_f32_16x16x32_bf16(*(const LAS bf16x8*)(Aa + 32), ba1, ca, 0, 0, 0);
#pragma unroll
                for (int ks = 0; ks < 4; ++ks) cgv = __builtin_amdgcn_mfma_f32_16x16x32_bf16(*(const LAS bf16x8*)(Ag + ks * 32), bg[ks], cgv, 0, 0, 0);
#pragma unroll
                for (int j = 0; j < 4; ++j) {
                    const int tok = mt * 16 + fq * 4 + j; const size_t o = (size_t)(m0 + tok) * 512 + col;
                    const float wv = -softplusf_(-(w0 + cw[j])) - 0.5f;
                    WEXP[o] = (bf16_t)f2bf(-__expf(wv));
                    const unsigned ab = f2bf(sigmoidf_(a0 + ca[j]));
                    AVp[o] = (bf16_t)ab; ALDS[tok * 64 + nt * 16 + fr] = bf2f(ab);
                    GGp[o] = (bf16_t)f2bf(cgv[j]);
                }
            }
        }
        LDS_WAIT();
        {
            const bf16_t* pr = PROJ + (size_t)m0 * NPROJ + C_CB + h * 64 + lane;
            float rprev, kprev;
            {
                const bool first0 = (m0 < MP) ? ((m0 & (SEQ - 1)) == 0) : true;
                if (!first0) { rprev = bf2f(*(pr - NPROJ)); kprev = bf2f(*(pr - NPROJ + 512)); }
                else if (m0 >= MP) { const float* sp = shs + (size_t)((m0 - MP) >> 2) * RWC + h * 64 + lane; rprev = sp[0]; kprev = sp[512]; }
                else { rprev = 0.f; kprev = 0.f; }
            }
#pragma unroll
            for (int t = 0; t < 16; ++t) rkraw2[t] = (unsigned)pr[(size_t)(16 + t) * NPROJ] | ((unsigned)pr[(size_t)(16 + t) * NPROJ + 512] << 16);
#pragma unroll
            for (int tb = 0; tb < 32; tb += 8) {
#pragma unroll
                for (int i = 0; i < 8; ++i) {
                    const int tok = tb + i, m = m0 + tok;
                    if (m >= MP && ((m - MP) & 3) == 0) { const float* sp = shs + (size_t)((m - MP) >> 2) * RWC + h * 64 + lane; rprev = sp[0]; kprev = sp[512]; }
                    const unsigned rkw = tok < 16 ? rkraw[tok & 15] : rkraw2[tok & 15];
                    const float rc = bf2f(rkw & 0xffffu), kc = bf2f(rkw >> 16);
                    const float r = rc + (rprev - rc) * mu_r, k = kc + (kprev - kc) * mu_k;
                    rprev = rc; kprev = kc;
                    const float kkr = k * c_kk; const float av = ALDS[tok * 64 + lane];
                    const float k2 = k * (1.f + (av - 1.f) * c_ka);
                    const float ssq = wave_sum_l63(kkr * kkr), rk = wave_sum_l63(r * k2 * c_rk);
                    if (lane == 63) { INV[(size_t)m * 8 + h] = 1.f / fmaxf(sqrtf(ssq), 1e-12f); RKR[(size_t)m * 8 + h] = rk; }
                }
            }
        }
    }
}

__device__ __forceinline__ int pop_job(unsigned* ctr, LAS int* slot, int tid) {
    __syncthreads();
    if (tid == 0) *slot = (int)atomicAdd(ctr, 1u);
    __syncthreads();
    return *slot;
}

__device__ __forceinline__ void rw_job(const Ctx& F0, int l, bool samp, int b, int h, int q) {
    const Ctx F = fresh(F0);
    CArgs a = get_args(); const int tid = F.tid, lane = F.lane, wave = F.wave, fr = lane & 15, fq = lane >> 4;
    const bf16_t* PROJ = (const bf16_t*)(a->ws + WS_PROJ);
    const bf16_t* WEXP = (const bf16_t*)(a->ws + WS_WEXP); const bf16_t* AVp = (const bf16_t*)(a->ws + WS_AV);
    const float* INV = (const float*)(a->ws + WS_INV); const float* RKR = (const float*)(a->ws + WS_RKR);
    bf16_t* BR = (bf16_t*)(a->ws + WS_BR); bf16_t* BOp = (bf16_t*)(a->ws + WS_BON);
    const int slen = samp ? SSEQ : SEQ; const size_t row0 = samp ? (size_t)MP + (size_t)b * SSEQ : (size_t)b * SEQ;
    const int nchunk = samp ? 1 : SEQ / 32, nvalid = samp ? SSEQ : 32;
    LAS float* OPS = (LAS float*)F.lds;
    LAS float* RK = OPS + 2 * 32 * 384;
    const bool scanw = wave < 4;
    const int cg = tid & 15;
    f32x4 mur, muk, muv, ckk, cka;
    {
        const float* mu = a->in[20] + l * RWC + h * 64 + cg * 4; const int chx = l * 512 + h * 64 + cg * 4;
        mur = *(const f32x4*)mu; muk = *(const f32x4*)(mu + 512); muv = *(const f32x4*)(mu + 1024);
        ckk = *(const f32x4*)(a->in[26] + chx); cka = *(const f32x4*)(a->in[27] + chx);
    }
    f32x4 S0 = (f32x4){0.f, 0.f, 0.f, 0.f}, S1 = S0;
    const int kq = lane & 7, rowi = lane >> 3;
    __syncthreads();
    for (int c = -1; c < nchunk; ++c) {
        if (!scanw) {
            const int cn = c + 1;
            if (cn < nchunk) {
                LAS float* ob = OPS + (cn & 1) * (32 * 384); LAS float* rkb = RK + (cn & 1) * 32;
#pragma unroll
                for (int i = 0; i < 2; ++i) {
                    const int it = (tid - 256) + 256 * i, tok = it >> 4;
                    if (tok < nvalid) {
                        const int tseq = cn * 32 + tok; const size_t m = row0 + tseq;
                        const bf16_t* pr = PROJ + m * NPROJ + C_CB + h * 64 + cg * 4;
                        const f32x4 rc = pg8::ld4(pr), kc = pg8::ld4(pr + 512), vc = pg8::ld4(pr + 1024);
                        f32x4 rp, kp, vp;
                        if (tseq > 0) { rp = pg8::ld4(pr - NPROJ); kp = pg8::ld4(pr - NPROJ + 512); vp = pg8::ld4(pr - NPROJ + 1024); }
                        else if (samp) { const float* sp = a->in[8] + ((size_t)l * NSB + b) * RWC + h * 64 + cg * 4; rp = *(const f32x4*)sp; kp = *(const f32x4*)(sp + 512); vp = *(const f32x4*)(sp + 1024); }
                        else { rp = (f32x4){0.f, 0.f, 0.f, 0.f}; kp = rp; vp = rp; }
                        const f32x4 r = rc + (rp - rc) * mur, k = kc + (kp - kc) * muk, v = vc + (vp - vc) * muv;
                        const f32x4 we = pg8::ld4(WEXP + m * 512 + h * 64 + cg * 4), av = pg8::ld4(AVp + m * 512 + h * 64 + cg * 4);
                        const float inv = INV[m * 8 + h];
                        f32x4 dec;
#pragma unroll
                        for (int j = 0; j < 4; ++j) dec[j] = __expf(we[j]);
                        const f32x4 kk = k * ckk * inv, k2 = k * ((av - 1.f) * cka + 1.f), kka = kk * av;
                        LAS float* o = ob + tok * 384 + cg * 4;
                        *(LAS f32x4*)(o) = dec; *(LAS f32x4*)(o + 64) = kk; *(LAS f32x4*)(o + 128) = kka; *(LAS f32x4*)(o + 192) = k2; *(LAS f32x4*)(o + 256) = r; *(LAS f32x4*)(o + 320) = v;
                        if (cg == 0) rkb[tok] = RKR[m * 8 + h];
                    }
                }
            }
        } else if (c >= 0) {
            const LAS float* ob = OPS + (c & 1) * (32 * 384); const LAS float* rkb = RK + (c & 1) * 32;
            const int nq = samp ? 2 : 1;
            for (int qq = 0; qq < nq; ++qq) {
                const int rowh = (samp ? qq : q) * 32 + wave * 8 + rowi;
                if (samp) { const float* sp = a->in[7] + ((((size_t)l * NSB + b) * 8 + h) * 64 + rowh) * 64 + kq * 8; S0 = *(const f32x4*)sp; S1 = *(const f32x4*)(sp + 4); }
                const LAS float* p = ob + kq * 8;
                float o0 = 0.f, o1 = 0.f, o2 = 0.f, o3 = 0.f, oc = 0.f;
#define RW_LOAD(X, tt_) do { const LAS float* p_ = p + (tt_) * 384; \
                    X##w0 = *(const LAS f32x4*)(p_); X##w1 = *(const LAS f32x4*)(p_ + 4); X##kk0 = *(const LAS f32x4*)(p_ + 64); X##kk1 = *(const LAS f32x4*)(p_ + 68); \
                    X##ka0 = *(const LAS f32x4*)(p_ + 128); X##ka1 = *(const LAS f32x4*)(p_ + 132); X##k0 = *(const LAS f32x4*)(p_ + 192); X##k1 = *(const LAS f32x4*)(p_ + 196); \
                    X##r0 = *(const LAS f32x4*)(p_ + 256); X##r1 = *(const LAS f32x4*)(p_ + 260); X##v = ob[(tt_) * 384 + 320 + rowh]; } while (0)
#define RW_STEP(X, tt_) do { \
                    const f32x4 pa_ = S0 * X##kk0 + S1 * X##kk1; float sk_ = (pa_[0] + pa_[1]) + (pa_[2] + pa_[3]); \
                    sk_ = DPP_ADD(sk_, 0xB1); sk_ = DPP_ADD(sk_, 0x4E); sk_ = DPP_ADD(sk_, 0x141); \
                    S0 = S0 * X##w0 + (X##k0 * X##v - X##ka0 * sk_); S1 = S1 * X##w1 + (X##k1 * X##v - X##ka1 * sk_); \
                    const f32x4 pb_ = S0 * X##r0 + S1 * X##r1; float o_ = (pb_[0] + pb_[1]) + (pb_[2] + pb_[3]); \
                    o_ = DPP_ADD(o_, 0xB1); o_ = DPP_ADD(o_, 0x4E); o_ = DPP_ADD(o_, 0x141); \
                    oc = (((tt_) & 7) == kq) ? o_ : oc; } while (0)
                f32x4 Aw0, Aw1, Akk0, Akk1, Aka0, Aka1, Ak0, Ak1, Ar0, Ar1, Bw0, Bw1, Bkk0, Bkk1, Bka0, Bka1, Bk0, Bk1, Br0, Br1; float Av, Bv;
                __builtin_amdgcn_s_setprio(3);
                RW_LOAD(A, 0);
                for (int t = 0; t < nvalid; t += 2) {
                    RW_LOAD(B, t + 1);
                    __builtin_amdgcn_sched_barrier(0);
                    RW_STEP(A, t);
                    { const int t2 = (t + 2 < 32) ? t + 2 : 31; RW_LOAD(A, t2); }
                    RW_STEP(B, t + 1);
                    __builtin_amdgcn_sched_barrier(0);
                    if (((t + 1) & 7) == 7 || t + 2 >= nvalid) { const int sl_ = (t + 1) >> 3; if (sl_ == 0) o0 = oc; else if (sl_ == 1) o1 = oc; else if (sl_ == 2) o2 = oc; else o3 = oc; }
                }
                __builtin_amdgcn_s_setprio(0);
#undef RW_LOAD
#undef RW_STEP
#pragma unroll
                for (int sl = 0; sl < 4; ++sl) {
                    const int t = sl * 8 + kq;
                    if (t < nvalid) {
                        const size_t m = row0 + (size_t)c * 32 + t;
                        BR[m * NBR + 1024 + h * 64 + rowh] = (bf16_t)f2bf(sl == 0 ? o0 : sl == 1 ? o1 : sl == 2 ? o2 : o3);
                        BOp[m * 512 + h * 64 + rowh] = (bf16_t)f2bf(rkb[t] * ob[t * 384 + 320 + rowh]);
                    }
                }
                if (samp) { float* sp = a->out + O_RWS + ((((size_t)l * NSB + b) * 8 + h) * 64 + rowh) * 64 + kq * 8; *(f32x4*)sp = S0; *(f32x4*)(sp + 4) = S1; }
            }
        }
        __syncthreads();
    }
    if (!samp && scanw) { const int rowh = q * 32 + wave * 8 + rowi; float* sp = a->out + O_RWP + ((((size_t)l * NB + b) * 8 + h) * 64 + rowh) * 64 + kq * 8; *(f32x4*)sp = S0; *(f32x4*)(sp + 4) = S1; }
    if (h == 0 && q == 0) {
        float* sh = a->out + (samp ? O_SHS + ((size_t)l * NSB + b) * RWC : O_SHP + ((size_t)l * NB + b) * RWC);
        for (int cidx = tid; cidx < RWC; cidx += 512) sh[cidx] = bf2f(PROJ[(row0 + slen - 1) * NPROJ + C_CB + cidx]);
    }
}

__device__ __forceinline__ void hg_pre(const Ctx& F0, int l) {
    const Ctx F = fresh(F0);
    CArgs a = get_args(); const int tid = F.tid, lane = F.lane, wave = F.wave, fr = lane & 15, fq = lane >> 4;
    const bf16_t* PROJ = (const bf16_t*)(a->ws + WS_PROJ);
    bf16_t* QSg = (bf16_t*)(a->ws + WS_HQS); float* O1g = (float*)(a->ws + WS_HO1); bf16_t* KVg = (bf16_t*)(a->ws + WS_HKV); float* EBg = (float*)(a->ws + WS_HEB); bf16_t* HGG = (bf16_t*)(a->ws + WS_HGG);
    LAS unsigned char* L = F.lds;
    constexpr int SQ = 136, SK = 72;
    LAS bf16_t* QT = (LAS bf16_t*)L; LAS bf16_t* QS = QT + 64 * SQ; LAS bf16_t* KT = QS + 64 * SQ;
    LAS bf16_t* KET = KT + 64 * SQ; LAS bf16_t* VT = KET + 128 * SK; LAS bf16_t* AM = VT + 128 * SK;
    LAS float* SEG = (LAS float*)(AM + 64 * SK);
    const int k = tid & 127, seg = tid >> 7;
    const int tt = wave & 3, vh = wave >> 2;
    for (int u = F.bid; u < 1024; u += F.G) {
        const int b = u >> 7, h = (u >> 5) & 3, c = u & 31;
        float lb = 0.f;
        if (l == 1) { const float l0 = a->in[18][h * 128 + k], l1 = a->in[18][512 + h * 128 + k]; const float mx = fmaxf(l0, l1); const float e0 = __expf(l0 - mx), e1 = __expf(l1 - mx); const float s0 = e0 / (e0 + e1), s1 = e1 / (e0 + e1); lb = (s0 + s1) - s0; }
        const float ngv = a->in[19][l * 512 + h * 128 + k];
        const size_t r0 = (size_t)b * SEQ + (size_t)c * 64;
        __syncthreads();
        float qs[16], kv[16], bc[16]; float run = 0.f;
        unsigned short rq[16], rf[16], rv[16], rg[16];
#pragma unroll
        for (int i = 0; i < 16; ++i) { const bf16_t* pp = PROJ + (r0 + seg * 16 + i) * NPROJ + h * 128 + k; rq[i] = pp[C_BQ]; rf[i] = pp[C_BF]; rv[i] = pp[C_BI]; rg[i] = pp[C_BG]; }
#pragma unroll
        for (int i = 0; i < 16; ++i) {
            const size_t r = r0 + seg * 16 + i;
            const float q = bf2f(rq[i]), fp = bf2f(rf[i]), gt = bf2f(rg[i]);
            VT[k * SK + seg * 16 + i] = rv[i];
            HGG[r * 512 + h * 128 + k] = (bf16_t)f2bf(ngv * siluf_(gt));
            const float ex = __expf(-fabsf(fp)); const float rcp = __builtin_amdgcn_rcpf(1.f + ex);
            const float sg = fp >= 0.f ? rcp : ex * rcp, sgn = fp >= 0.f ? ex * rcp : rcp;
            const float f = lb + (1.f - lb) * sg;
            kv[i] = (1.f - lb) * sgn;
            qs[i] = siluf_(q);
            run += __logf(fmaxf(f, 1e-20f)); bc[i] = run;
        }
        SEG[seg * 128 + k] = run;
        __syncthreads();
        {
            const float s0 = SEG[k], s1 = SEG[128 + k], s2 = SEG[256 + k], s3 = SEG[384 + k];
            const float off = seg == 0 ? 0.f : seg == 1 ? s0 : seg == 2 ? s0 + s1 : s0 + s1 + s2;
            const float ref = s0 + s1, btot = (s0 + s1) + (s2 + s3);
            if (seg == 0) EBg[(size_t)u * 128 + k] = __expf(btot);
#pragma unroll
            for (int i = 0; i < 16; ++i) {
                const float bb = off + bc[i]; const int t = seg * 16 + i;
                QS[t * SQ + k] = (bf16_t)f2bf(qs[i] * __expf(bb));
                QT[t * SQ + k] = (bf16_t)f2bf(qs[i] * __expf(bb - ref));
                KT[t * SQ + k] = (bf16_t)f2bf(kv[i] * __expf(ref - bb));
                KET[k * SK + t] = (bf16_t)f2bf(kv[i] * __expf(btot - bb));
            }
        }
        __syncthreads();
        { const int t = tid >> 3, c0 = (tid & 7) * 16; const LAS u32x4* sp = (const LAS u32x4*)(QS + t * SQ + c0); u32x4* dp = (u32x4*)(QSg + ((size_t)u * 64 + t) * 128 + c0); dp[0] = sp[0]; dp[1] = sp[1]; }
#pragma unroll
        for (int si = 0; si < 2; ++si) {
            const int st = vh * 2 + si;
            f32x4 acc = (f32x4){0.f, 0.f, 0.f, 0.f};
            if (st <= tt) {
#pragma unroll
                for (int ks = 0; ks < 4; ++ks)
                    acc = __builtin_amdgcn_mfma_f32_16x16x32_bf16(*(const LAS bf16x8*)(QT + (tt * 16 + fr) * SQ + ks * 32 + fq * 8), *(const LAS bf16x8*)(KT + (st * 16 + fr) * SQ + ks * 32 + fq * 8), acc, 0, 0, 0);
            }
#pragma unroll
            for (int j = 0; j < 4; ++j) { const int t = tt * 16 + fq * 4 + j, s = st * 16 + fr; AM[t * SK + s] = (bf16_t)f2bf((st <= tt && t >= s) ? acc[j] : 0.f); }
        }
#pragma unroll
        for (int vt = 0; vt < 8; ++vt) {
            f32x4 acc = (f32x4){0.f, 0.f, 0.f, 0.f};
#pragma unroll
            for (int ks = 0; ks < 2; ++ks)
                acc = __builtin_amdgcn_mfma_f32_16x16x32_bf16(*(const LAS bf16x8*)(KET + (wave * 16 + fr) * SK + ks * 32 + fq * 8), *(const LAS bf16x8*)(VT + (vt * 16 + fr) * SK + ks * 32 + fq * 8), acc, 0, 0, 0);
            u32x2 w; w.x = pk2(acc[0], acc[1]); w.y = pk2(acc[2], acc[3]);
            *(u32x2*)(KVg + (((size_t)u * 64 + wave * 8 + vt) * 64 + lane) * 4) = w;
        }
        __syncthreads();
#pragma unroll
        for (int vi = 0; vi < 4; ++vi) {
            const int vt = vh * 4 + vi; f32x4 acc = (f32x4){0.f, 0.f, 0.f, 0.f};
#pragma unroll
            for (int ks = 0; ks < 2; ++ks)
                acc = __builtin_amdgcn_mfma_f32_16x16x32_bf16(*(const LAS bf16x8*)(AM + (tt * 16 + fr) * SK + ks * 32 + fq * 8), *(const LAS bf16x8*)(VT + (vt * 16 + fr) * SK + ks * 32 + fq * 8), acc, 0, 0, 0);
            *(f32x4*)(O1g + (((size_t)u * 32 + tt * 8 + vt) * 64 + lane) * 4) = acc;
        }
    }
}

__device__ __forceinline__ void hg_seq_job(const Ctx& F0, int l, int b, int h, int vs) {
    const Ctx F = fresh(F0);
    CArgs a = get_args(); const int tid = F.tid, lane = F.lane, wave = F.wave, fr = lane & 15, fq = lane >> 4;
    const bf16_t* QSg = (const bf16_t*)(a->ws + WS_HQS); const float* O1g = (const float*)(a->ws + WS_HO1); const bf16_t* KVg = (const bf16_t*)(a->ws + WS_HKV); const float* EBg = (const float*)(a->ws + WS_HEB);
    bf16_t* BR = (bf16_t*)(a->ws + WS_BR);
    constexpr int SQ = 136;
    LAS bf16_t* ST = (LAS bf16_t*)F.lds;
    const int tt = wave & 3, vtl = wave >> 2, kt = wave;
    __syncthreads();
    for (int i = tid; i < 32 * SQ; i += 512) ST[i] = 0;
    f32x4 Sacc[2] = {(f32x4){0.f, 0.f, 0.f, 0.f}, (f32x4){0.f, 0.f, 0.f, 0.f}};
    const int u0 = (b * 4 + h) * 32;
    bf16x8 qf[4]; f32x4 o1; u32x2 kvr[2]; f32x4 eb;
#define HG_PREFETCH(cc) do { const size_t u = (size_t)(u0 + (cc)); \
        _Pragma("unroll") for (int ks = 0; ks < 4; ++ks) qf[ks] = *(const bf16x8*)(QSg + (u * 64 + tt * 16 + fr) * 128 + ks * 32 + fq * 8); \
        o1 = *(const f32x4*)(O1g + ((u * 32 + tt * 8 + vs * 2 + vtl) * 64 + lane) * 4); \
        _Pragma("unroll") for (int i = 0; i < 2; ++i) kvr[i] = *(const u32x2*)(KVg + ((u * 64 + kt * 8 + vs * 2 + i) * 64 + lane) * 4); \
        eb = *(const f32x4*)(EBg + u * 128 + kt * 16 + fq * 4); } while (0)
    HG_PREFETCH(0);
    __syncthreads();
    for (int c = 0; c < 32; ++c) {
        const bf16x8 q0 = qf[0], q1 = qf[1], q2 = qf[2], q3 = qf[3]; f32x4 acc = o1; const u32x2 kv0 = kvr[0], kv1 = kvr[1]; const f32x4 ebc = eb;
        if (c + 1 < 32) HG_PREFETCH(c + 1);
        const LAS bf16_t* Sb = ST + (c & 1) * (32 * SQ) + (vtl * 16 + fr) * SQ + fq * 8;
        acc = __builtin_amdgcn_mfma_f32_16x16x32_bf16(q0, *(const LAS bf16x8*)(Sb), acc, 0, 0, 0);
        acc = __builtin_amdgcn_mfma_f32_16x16x32_bf16(q1, *(const LAS bf16x8*)(Sb + 32), acc, 0, 0, 0);
        acc = __builtin_amdgcn_mfma_f32_16x16x32_bf16(q2, *(const LAS bf16x8*)(Sb + 64), acc, 0, 0, 0);
        acc = __builtin_amdgcn_mfma_f32_16x16x32_bf16(q3, *(const LAS bf16x8*)(Sb + 96), acc, 0, 0, 0);
        const size_t r0 = (size_t)b * SEQ + (size_t)c * 64;
#pragma unroll
        for (int j = 0; j < 4; ++j) BR[(r0 + tt * 16 + fq * 4 + j) * NBR + 512 + h * 128 + vs * 32 + vtl * 16 + fr] = (bf16_t)f2bf(acc[j]);
        LAS bf16_t* Sn = ST + ((c + 1) & 1) * (32 * SQ);
#pragma unroll
        for (int i = 0; i < 2; ++i) {
            const u32x2 kw = i == 0 ? kv0 : kv1;
            const f32x4 kvv = (f32x4){bf2f(kw.x & 0xffffu), bf2f(kw.x >> 16), bf2f(kw.y & 0xffffu), bf2f(kw.y >> 16)};
            Sacc[i] = Sacc[i] * ebc + kvv;
            u32x2 w; w.x = pk2(Sacc[i][0], Sacc[i][1]); w.y = pk2(Sacc[i][2], Sacc[i][3]);
            *(LAS u32x2*)(Sn + (i * 16 + fr) * SQ + kt * 16 + fq * 4) = w;
        }
        __syncthreads();
    }
#undef HG_PREFETCH
    float* so = a->out + O_HGP + (((size_t)l * NB + b) * 4 + h) * 128 * 128;
#pragma unroll
    for (int i = 0; i < 2; ++i)
#pragma unroll
        for (int j = 0; j < 4; ++j) so[(size_t)(kt * 16 + fq * 4 + j) * 128 + vs * 32 + i * 16 + fr] = Sacc[i][j];
}

__device__ __forceinline__ void hg_finish(const Ctx& F0) {
    const Ctx F = fresh(F0);
    CArgs a = get_args();
    const bf16_t* HGG = (const bf16_t*)(a->ws + WS_HGG); bf16_t* BR = (bf16_t*)(a->ws + WS_BR);
    const int gw = F.bid * 8 + F.wave, NGW = F.G * 8, lane = F.lane;
    for (int it0 = gw * 4; it0 < MP * 4; it0 += NGW * 4) {
        unsigned ov[4], gq[4]; unsigned* op[4];
#pragma unroll
        for (int q = 0; q < 4; ++q) { const int it = it0 + q, m = it >> 2, h = it & 3; op[q] = (unsigned*)(BR + (size_t)m * NBR + 512 + h * 128) + lane; ov[q] = *op[q]; gq[q] = *((const unsigned*)(HGG + (size_t)m * 512 + h * 128) + lane); }
#pragma unroll
        for (int q = 0; q < 4; ++q) { const float oa = bf2f(ov[q] & 0xffffu), ob = bf2f(ov[q] >> 16);
            const float rs = rsqrtf(wave_sum_all(oa * oa + ob * ob) * (1.f / 128.f) + EPS);
            *op[q] = pk2(oa * rs * bf2f(gq[q] & 0xffffu), ob * rs * bf2f(gq[q] >> 16)); }
    }
}

__device__ __forceinline__ void hg_sample_job(const Ctx& F0, int l, int b, int h) {
    const Ctx F = fresh(F0);
    CArgs a = get_args(); const int tid = F.tid, lane = F.lane, wave = F.wave;
    const bf16_t* PROJ = (const bf16_t*)(a->ws + WS_PROJ); bf16_t* BR = (bf16_t*)(a->ws + WS_BR);
    LAS float* FF = (LAS float*)F.lds;
    LAS float* KV = FF + 512; LAS float* QSs = KV + 512; LAS float* VV = QSs + 512;
    LAS float* RED = VV + 512;
    LAS float* SSQ = RED + 8192;
    const size_t row0 = (size_t)MP + (size_t)b * SSEQ;
    __syncthreads();
    {
        const int t = tid >> 7, k = tid & 127;
        float lb = 0.f;
        if (l == 1) { const float l0 = a->in[18][h * 128 + k], l1 = a->in[18][512 + h * 128 + k]; const float mx = fmaxf(l0, l1); const float e0 = __expf(l0 - mx), e1 = __expf(l1 - mx); const float s0 = e0 / (e0 + e1), s1 = e1 / (e0 + e1); lb = (s0 + s1) - s0; }
        const size_t r = row0 + t;
        const float q = bf2f(PROJ[r * NPROJ + C_BQ + h * 128 + k]), fp = bf2f(PROJ[r * NPROJ + C_BF + h * 128 + k]);
        const float ex = __expf(-fp), sg = 1.f / (1.f + ex);
        const float f = lb + (1.f - lb) * sg;
        FF[tid] = __expf(__logf(fmaxf(f, 1e-20f)));
        KV[tid] = (1.f - lb) * (fp > 0.f ? ex * sg : 1.f / (1.f + __expf(fp)));
        QSs[tid] = siluf_(q);
        VV[tid] = bf2f(PROJ[r * NPROJ + C_BI + h * 128 + k]);
    }
    const int v4 = tid & 31, kg = tid >> 5;
    const float* s0 = a->in[6] + (((size_t)l * NSB + b) * 4 + h) * 128 * 128;
    f32x4 S[8];
#pragma unroll
    for (int i = 0; i < 8; ++i) S[i] = *(const f32x4*)(s0 + (size_t)(kg * 8 + i) * 128 + v4 * 4);
    __syncthreads();
#pragma unroll
    for (int t = 0; t < 4; ++t) {
        const f32x4 vv = *(const LAS f32x4*)(VV + t * 128 + v4 * 4); f32x4 po = (f32x4){0.f, 0.f, 0.f, 0.f};
#pragma unroll
        for (int i = 0; i < 8; ++i) { const int kx = t * 128 + kg * 8 + i; S[i] = S[i] * FF[kx] + vv * KV[kx]; po = po + S[i] * QSs[kx]; }
        *(LAS f32x4*)(RED + (t * 16 + kg) * 128 + v4 * 4) = po;
    }
    float* so = a->out + O_HGS + (((size_t)l * NSB + b) * 4 + h) * 128 * 128;
#pragma unroll
    for (int i = 0; i < 8; ++i) *(f32x4*)(so + (size_t)(kg * 8 + i) * 128 + v4 * 4) = S[i];
    __syncthreads();
    {
        const int t = tid >> 7, v = tid & 127; float o = 0.f;
#pragma unroll
        for (int g = 0; g < 16; ++g) o += RED[(t * 16 + g) * 128 + v];
        const float p = wave_sum(o * o);
        if (lane == 0) SSQ[wave] = p;
        __syncthreads();
        const float rs = rsqrtf((SSQ[t * 2] + SSQ[t * 2 + 1]) * (1.f / 128.f) + EPS);
        const size_t r = row0 + t;
        const float gt = bf2f(PROJ[r * NPROJ + C_BG + h * 128 + v]);
        BR[r * NBR + 512 + h * 128 + v] = (bf16_t)f2bf(o * rs * a->in[19][l * 512 + h * 128 + v] * siluf_(gt));
    }
}

__device__ __forceinline__ void lru_job(const Ctx& F0, int l, bool samp, int bidx, int blk) {
    const Ctx F = fresh(F0);
    CArgs a = get_args(); const int tid = F.tid, lane = F.lane, wave = F.wave, fr = lane & 15, fq = lane >> 4;
    const bf16_t* PROJ = (const bf16_t*)(a->ws + WS_PROJ); bf16_t* BR = (bf16_t*)(a->ws + WS_BR);
    LAS float* XC = (LAS float*)F.lds;
    LAS float* AS = XC + 4096; LAS float* BS = AS + 4096;
    LAS float* SEGA = BS + 4096; LAS float* SEGB = SEGA + 512;
    LAS float* CARRY = SEGB + 512;
    LAS bf16_t* XCB = (LAS bf16_t*)(CARRY + 64);
    const size_t row0 = samp ? (size_t)MP + (size_t)bidx * 64 : (size_t)bidx * SEQ;
    const int nchunk = samp ? 1 : SEQ / 64;
    const int cc = tid & 63, tq = tid >> 6, ch = blk * 64 + cc;
    const float cw0 = a->in[11][(l * 4 + 0) * 512 + ch], cw1 = a->in[11][(l * 4 + 1) * 512 + ch], cw2 = a->in[11][(l * 4 + 2) * 512 + ch], cw3 = a->in[11][(l * 4 + 3) * 512 + ch];
    const float cb = a->in[12][l * 512 + ch];
    bf16x8 Ba[2][2], Bx[2][2];
#pragma unroll
    for (int ji = 0; ji < 2; ++ji) { const int j = ((wave >> 2) * 2 + ji) * 16 + fr;
        const bf16_t* wa = (const bf16_t*)(a->ws + WS_W + W_LWA) + blk * 4096 + j * 64; const bf16_t* wx = (const bf16_t*)(a->ws + WS_W + W_LWX) + blk * 4096 + j * 64;
#pragma unroll
        for (int ks = 0; ks < 2; ++ks) { Ba[ji][ks] = *(const bf16x8*)(wa + ks * 32 + fq * 8); Bx[ji][ks] = *(const bf16x8*)(wx + ks * 32 + fq * 8); } }
    __syncthreads();
    if (tid < 64) CARRY[tid] = 0.f;
    for (int c = 0; c < nchunk; ++c) {
        {
            float x[11];
#pragma unroll
            for (int i = 0; i < 11; ++i) {
                const long p = (long)c * 64 + tq * 8 + i - 3;
                x[i] = (!samp && p >= 0) ? bf2f(PROJ[(row0 + p) * NPROJ + C_XA + ch]) : 0.f;
            }
#pragma unroll
            for (int i = 0; i < 8; ++i) {
                const int t = tq * 8 + i; float x0 = x[i], x1 = x[i + 1], x2 = x[i + 2], x3 = x[i + 3];
                if (samp) {
                    const int tl = t & 3, bb = bidx * 16 + (t >> 2);
                    const float* cs = a->in[4] + ((size_t)l * NSB + bb) * 3 * 512 + ch;
                    const bf16_t* pr = PROJ + (row0 + t) * NPROJ + C_XA + ch;
                    x3 = bf2f(pr[0]);
                    x2 = (tl >= 1) ? bf2f(*(pr - (size_t)NPROJ)) : cs[(size_t)(2 + tl) * 512];
                    x1 = (tl >= 2) ? bf2f(*(pr - (size_t)2 * NPROJ)) : cs[(size_t)(1 + tl) * 512];
                    x0 = (tl >= 3) ? bf2f(*(pr - (size_t)3 * NPROJ)) : cs[(size_t)(tl) * 512];
                }
                const float xc = cb + x0 * cw0 + x1 * cw1 + x2 * cw2 + x3 * cw3;
                XC[t * 64 + cc] = xc; XCB[t * 72 + cc] = (bf16_t)f2bf(xc);
            }
        }
        __syncthreads();
        {
            const int tt = wave & 3;
#pragma unroll
            for (int ji = 0; ji < 2; ++ji) {
                f32x4 ar = (f32x4){0.f, 0.f, 0.f, 0.f}, ax = ar;
#pragma unroll
                for (int ks = 0; ks < 2; ++ks) { const bf16x8 av = *(const LAS bf16x8*)(XCB + (tt * 16 + fr) * 72 + ks * 32 + fq * 8);
                    ar = __builtin_amdgcn_mfma_f32_16x16x32_bf16(av, Ba[ji][ks], ar, 0, 0, 0); ax = __builtin_amdgcn_mfma_f32_16x16x32_bf16(av, Bx[ji][ks], ax, 0, 0, 0); }
                const int j = ((wave >> 2) * 2 + ji) * 16 + fr, chj = blk * 64 + j;
                const float ba = a->in[14][l * 512 + chj], bx = a->in[16][l * 512 + chj], sp = softplusf_(-a->in[17][l * 512 + chj]);
#pragma unroll
                for (int jj = 0; jj < 4; ++jj) {
                    const int t = tt * 16 + fq * 4 + jj;
                    const float rg = sigmoidf_(ar[jj] + ba), ig = sigmoidf_(ax[jj] + bx);
                    const float la = -8.f * rg * sp; float av = __expf(la);
                    const bool first = samp ? ((t & 3) == 0) : (c == 0 && t == 0);
                    float mult = sqrtf(fmaxf(-expm1f(2.f * la), 0.f));
                    if (!samp && first) mult = 1.f;
                    float bv = XC[t * 64 + j] * ig * mult;
                    if (first) { const float h0 = samp ? a->in[5][((size_t)l * NSB + bidx * 16 + (t >> 2)) * 512 + chj] : 0.f; bv += av * h0; av = 0.f; }
                    AS[t * 64 + j] = av; BS[t * 64 + j] = bv;
                }
            }
        }
        __syncthreads();
        {
            float Ai[8], Bi[8]; float A = 1.f, B = 0.f;
#pragma unroll
            for (int i = 0; i < 8; ++i) { const int t = tq * 8 + i; const float av = AS[t * 64 + cc], bv = BS[t * 64 + cc]; B = av * B + bv; A = av * A; Ai[i] = A; Bi[i] = B; }
            SEGA[tq * 64 + cc] = A; SEGB[tq * 64 + cc] = B;
            __syncthreads();
            float hin = CARRY[cc];
            for (int s = 0; s < tq; ++s) hin = SEGA[s * 64 + cc] * hin + SEGB[s * 64 + cc];
            float hl = 0.f;
#pragma unroll
            for (int i = 0; i < 8; ++i) {
                const int t = tq * 8 + i; const size_t r = row0 + (size_t)c * 64 + t;
                const float hv = Ai[i] * hin + Bi[i]; hl = hv;
                const float gav = bf2f(PROJ[r * NPROJ + C_GA + ch]);
                BR[r * NBR + ch] = (bf16_t)f2bf(hv * gelu_tanh(gav));
                if (samp && (t & 3) == 3) a->out[O_LRUS + ((size_t)l * NSB + bidx * 16 + (t >> 2)) * 512 + ch] = hv;
            }
            __syncthreads();
            if (tq == 7) { CARRY[cc] = hl; if (!samp && c == nchunk - 1) a->out[O_LRUP + ((size_t)l * NB + bidx) * 512 + ch] = hl; }
        }
        __syncthreads();
    }
    if (!samp) { if (tid < 192) { const int j = tid >> 6; a->out[O_CONVP + (((size_t)l * NB + bidx) * 3 + j) * 512 + ch] = bf2f(PROJ[(row0 + SEQ - 3 + j) * NPROJ + C_XA + ch]); } }
    else { for (int e = tid; e < 16 * 3 * 64; e += 512) { const int c2 = e & 63, j = (e >> 6) % 3, bb = e / 192;
            a->out[O_CONVS + (((size_t)l * NSB + bidx * 16 + bb) * 3 + j) * 512 + blk * 64 + c2] = bf2f(PROJ[(row0 + bb * 4 + 1 + j) * NPROJ + C_XA + blk * 64 + c2]); } }
}

__device__ __forceinline__ void lru_pre(const Ctx& F0, int l) {
    const Ctx F = fresh(F0);
    CArgs a = get_args(); const int tid = F.tid, lane = F.lane, wave = F.wave, fr = lane & 15, fq = lane >> 4;
    const bf16_t* PROJ = (const bf16_t*)(a->ws + WS_PROJ); bf16_t* BR = (bf16_t*)(a->ws + WS_BR); bf16_t* LLA = (bf16_t*)(a->ws + WS_LLA);
    LAS float* XC = (LAS float*)F.lds;
    LAS bf16_t* XCB = (LAS bf16_t*)(XC + 4096);
    const int cc = tid & 63, tq = tid >> 6;
    for (int u = F.bid; u < 2048; u += F.G) {
        const int tile = u >> 3, blk = u & 7, c = tile & 31, ch = blk * 64 + cc; const size_t r0 = (size_t)tile * 64;
        const float cw0 = a->in[11][(l * 4 + 0) * 512 + ch], cw1 = a->in[11][(l * 4 + 1) * 512 + ch], cw2 = a->in[11][(l * 4 + 2) * 512 + ch], cw3 = a->in[11][(l * 4 + 3) * 512 + ch];
        const float cb = a->in[12][l * 512 + ch];
        __syncthreads();
        {
            float x[11];
#pragma unroll
            for (int i = 0; i < 11; ++i) { const int p = c * 64 + tq * 8 + i - 3; x[i] = p >= 0 ? bf2f(PROJ[(r0 + tq * 8 + i - 3) * NPROJ + C_XA + ch]) : 0.f; }
#pragma unroll
            for (int i = 0; i < 8; ++i) { const int t = tq * 8 + i; const float xc = cb + x[i] * cw0 + x[i + 1] * cw1 + x[i + 2] * cw2 + x[i + 3] * cw3; XC[t * 64 + cc] = xc; XCB[t * 72 + cc] = (bf16_t)f2bf(xc); }
        }
        __syncthreads();
        {
            const int tt = wave & 3;
#pragma unroll
            for (int ji = 0; ji < 2; ++ji) {
                const int j = ((wave >> 2) * 2 + ji) * 16 + fr, chj = blk * 64 + j;
                const bf16_t* wa = (const bf16_t*)(a->ws + WS_W + W_LWA) + blk * 4096 + j * 64; const bf16_t* wx = (const bf16_t*)(a->ws + WS_W + W_LWX) + blk * 4096 + j * 64;
                f32x4 ar = (f32x4){0.f, 0.f, 0.f, 0.f}, ax = ar;
#pragma unroll
                for (int ks = 0; ks < 2; ++ks) { const bf16x8 av = *(const LAS bf16x8*)(XCB + (tt * 16 + fr) * 72 + ks * 32 + fq * 8);
                    ar = __builtin_amdgcn_mfma_f32_16x16x32_bf16(av, *(const bf16x8*)(wa + ks * 32 + fq * 8), ar, 0, 0, 0); ax = __builtin_amdgcn_mfma_f32_16x16x32_bf16(av, *(const bf16x8*)(wx + ks * 32 + fq * 8), ax, 0, 0, 0); }
                const float ba = a->in[14][l * 512 + chj], bx = a->in[16][l * 512 + chj], sp = softplusf_(-a->in[17][l * 512 + chj]);
#pragma unroll
                for (int jj = 0; jj < 4; ++jj) {
                    const int t = tt * 16 + fq * 4 + jj;
                    const float rg = sigmoidf_(ar[jj] + ba), ig = sigmoidf_(ax[jj] + bx);
                    float la = -8.f * rg * sp;
                    const bool first = (c == 0 && t == 0);
                    const float mult = first ? 1.f : sqrtf(fmaxf(-expm1f(2.f * la), 0.f));
                    const float bv = XC[t * 64 + j] * ig * mult;
                    if (first) la = -__builtin_inff();
                    BR[(r0 + t) * NBR + chj] = (bf16_t)f2bf(bv); LLA[(r0 + t) * 512 + chj] = (bf16_t)f2bf(la);
                }
            }
        }
    }
}

__device__ __forceinline__ void lru_seq_job(const Ctx& F0, int l, int b, int blk) {
    const Ctx F = fresh(F0);
    CArgs a = get_args(); const int tid = F.tid;
    const bf16_t* PROJ = (const bf16_t*)(a->ws + WS_PROJ); bf16_t* BR = (bf16_t*)(a->ws + WS_BR); const bf16_t* LLA = (const bf16_t*)(a->ws + WS_LLA);
    LAS float* SEGA = (LAS float*)F.lds; LAS float* SEGB = SEGA + 512;
    const int cc = tid & 63, sg = tid >> 6, ch = blk * 64 + cc; const size_t row0 = (size_t)b * SEQ + (size_t)sg * 256;
    float A = 1.f, B = 0.f;
#pragma unroll 1
    for (int tb = 0; tb < 256; tb += 16) {
        unsigned short la[16], bb[16];
#pragma unroll
        for (int i = 0; i < 16; ++i) { la[i] = LLA[(row0 + tb + i) * 512 + ch]; bb[i] = BR[(row0 + tb + i) * NBR + ch]; }
#pragma unroll
        for (int i = 0; i < 16; ++i) { const float av = __expf(bf2f(la[i])), bv = bf2f(bb[i]); B = av * B + bv; A = av * A; }
    }
    __syncthreads();
    SEGA[sg * 64 + cc] = A; SEGB[sg * 64 + cc] = B;
    __syncthreads();
    float h = 0.f;
    for (int s = 0; s < sg; ++s) h = SEGA[s * 64 + cc] * h + SEGB[s * 64 + cc];
#pragma unroll 1
    for (int tb = 0; tb < 256; tb += 16) {
        unsigned short la[16], bb[16], ga[16];
#pragma unroll
        for (int i = 0; i < 16; ++i) { la[i] = LLA[(row0 + tb + i) * 512 + ch]; bb[i] = BR[(row0 + tb + i) * NBR + ch]; ga[i] = PROJ[(row0 + tb + i) * NPROJ + C_GA + ch]; }
#pragma unroll
        for (int i = 0; i < 16; ++i) {
            h = __expf(bf2f(la[i])) * h + bf2f(bb[i]);
            BR[(row0 + tb + i) * NBR + ch] = (bf16_t)f2bf(h * gelu_tanh(bf2f(ga[i])));
        }
    }
    if (sg == 7) a->out[O_LRUP + ((size_t)l * NB + b) * 512 + ch] = h;
    if (tid < 192) { const int j = tid >> 6; a->out[O_CONVP + (((size_t)l * NB + b) * 3 + j) * 512 + ch] = bf2f(PROJ[((size_t)b * SEQ + SEQ - 3 + j) * NPROJ + C_XA + ch]); }
}

__device__ __forceinline__ void scan_phase(const Ctx& F, int l) {
    unsigned* ctrA = (unsigned*)(get_args()->ws + WS_CTL) + 64 * l;
    unsigned* ctrB = (unsigned*)(get_args()->ws + WS_CTL) + 64 * l + 128;
    LAS int* slot = (LAS int*)(F.lds + LDS_BYTES - 16);
    const Ctx Fq = fresh(F);
    constexpr int J_HGP = 128, J_LRUP = 64, J_LRUS = 64, J_HGS = 512, J_RWS = 1024;
    const bool split = (F.G == 256);
    int stage = split ? (F.bid < 128 ? 0 : 1) : 3;
    for (;;) {
        int type = -1, p0 = 0, p1 = 0, p2 = 0; bool samp = false;
        if (stage == 0) { const int j = F.bid; type = 0; p0 = j >> 4; p1 = (j >> 1) & 7; p2 = j & 1; stage = 2; }
        else if (stage == 1 || stage == 3) {
            int j = pop_job(ctrA, slot, Fq.tid);
            if (stage == 3 && j < 128) { type = 0; p0 = j >> 4; p1 = (j >> 1) & 7; p2 = j & 1; }
            else {
                if (stage == 3) j -= 128;
                if (j < J_HGP) { type = 1; p0 = j >> 4; p1 = (j >> 2) & 3; p2 = j & 3; }
                else if ((j -= J_HGP) < J_LRUP) { type = 4; p0 = j >> 3; p1 = j & 7; }
                else {
                    unsigned char* wsb = get_args()->ws;
                    pg8::Gemm g{(const bf16_t*)(wsb + WS_XN), (const bf16_t*)(wsb + WS_W + W_IN + (size_t)NPROJ * D * 2), D, D, D};
                    pg8::Order S; if (stage == 1) S.init(M, NGATE, 128, F.bid - 128, 0); else S.init(M, NGATE, F.G, F.bid, 0);
                    pg8::Epi E{pg8::EP_SIGMOID, (bf16_t*)(wsb + WS_G2), NGATE, nullptr, 0};
                    pg8::gemm_phase(F.lds, F.wave, g, S, E);
                    stage = 2; continue;
                }
            }
        } else {
            int j = pop_job(ctrB, slot, Fq.tid);
            if (j >= J_LRUS + J_HGS + J_RWS) break;
            if (j < J_LRUS) { type = 2; samp = true; p0 = j >> 3; p1 = j & 7; }
            else if ((j -= J_LRUS) < J_HGS) { type = 3; p0 = j >> 2; p1 = j & 3; }
            else { j -= J_HGS; type = 0; samp = true; p0 = j >> 3; p1 = j & 7; p2 = 0; }
        }
        if (type == 0) rw_job(F, l, samp, p0, p1, p2);
        else if (type == 1) hg_seq_job(F, l, p0, p1, p2);
        else if (type == 2) lru_job(F, l, samp, p0, p1);
        else if (type == 4) lru_seq_job(F, l, p0, p1);
        else hg_sample_job(F, l, p0, p1);
    }
}

__device__ __forceinline__ void sample_gemm(const Ctx& F0, const bf16_t* A, int lda, const bf16_t* Bt, int K, int mode, bf16_t* O, const bf16_t* G, int three) {
    const Ctx F = fresh(F0); const int lane = F.lane, wave = F.wave, fr = lane & 15, fq = lane >> 4;
    for (int tile = F.bid; tile < 256; tile += F.G) {
        const int row0 = MP + (tile >> 4) * 32 + (wave & 1) * 16, col0 = (tile & 15) * 64 + (wave >> 1) * 16;
        f32x4 sacc = (f32x4){0.f, 0.f, 0.f, 0.f};
        const int nparts = three ? 3 : 1;
        for (int n = 0; n < nparts; ++n) {
            const bf16_t* Ap = A + (size_t)(row0 + fr) * lda + n * 512 + fq * 8;
            const bf16_t* Bp = Bt + (size_t)(n * 1024 + col0 + fr) * K + fq * 8;
            f32x4 acc = (f32x4){0.f, 0.f, 0.f, 0.f};
#pragma unroll 1
            for (int k0 = 0; k0 < K; k0 += 256) {
                bf16x8 av[8], bv[8];
#pragma unroll
                for (int i = 0; i < 8; ++i) { av[i] = *(const bf16x8*)(Ap + k0 + i * 32); bv[i] = *(const bf16x8*)(Bp + k0 + i * 32); }
#pragma unroll
                for (int i = 0; i < 8; ++i) acc = __builtin_amdgcn_mfma_f32_16x16x32_bf16(av[i], bv[i], acc, 0, 0, 0);
            }
            if (three) {
#pragma unroll
                for (int j = 0; j < 4; ++j) sacc[j] += acc[j] * bf2f(G[(size_t)(row0 + fq * 4 + j) * NGATE + n * 1024 + col0 + fr]);
            } else sacc = acc;
        }
#pragma unroll
        for (int j = 0; j < 4; ++j) {
            bf16_t* op = O + (size_t)(row0 + fq * 4 + j) * D + col0 + fr; float v = sacc[j];
            if (mode == pg8::EP_SIGMOID) v = sigmoidf_(v);
            if (mode == pg8::EP_MULINPLACE) v *= bf2f(*op);
            *op = (bf16_t)f2bf(v);
        }
    }
}

#define XB_TMO      128
#define XB_XCNT(j)  (256  + 64 * (j))
#define XB_XSUB(j)  (1280 + 64 * (j))
#define XB_XGEN(j)  (2304 + 64 * (j))
#define XB_TOP      3328
#define XB_TOPGEN   3392
#define XCD_BAR_WORDS 3456
#define XB_SPIN_CAP (1u << 22)
__device__ __forceinline__ unsigned xb_ld(unsigned* p)              { return __hip_atomic_load(p, __ATOMIC_RELAXED, __HIP_MEMORY_SCOPE_AGENT); }
__device__ __forceinline__ unsigned xb_add(unsigned* p, unsigned v) { return __hip_atomic_fetch_add(p, v, __ATOMIC_RELAXED, __HIP_MEMORY_SCOPE_AGENT); }
__device__ __forceinline__ unsigned xb_xcc_id() { return (unsigned)__builtin_amdgcn_s_getreg((3 << 11) | 20) & 0xFu; }
#define XB_SPIN(cond, bar) do { unsigned _sp = 0; while (cond) { __builtin_amdgcn_s_sleep(1); \
    if ((++_sp & 255u) == 0u) { if (xb_ld(&(bar)[XB_TMO])) break; if (_sp > XB_SPIN_CAP) { atomicAdd(&(bar)[XB_TMO], 1u); break; } } } } while (0)
__device__ __forceinline__ void xcd_barrier_complete(unsigned* bar, unsigned x, unsigned G, unsigned& nloc, unsigned& nx) {
    unsigned sum, cnt, mine, sp = 0u;
    for (;;) {
        sum = 0u; cnt = 0u; mine = 0u;
#pragma unroll
        for (unsigned j = 0; j < 16; ++j) { const unsigned c = xb_ld(&bar[XB_XCNT(j)]); sum += c; cnt += (c > 0u) ? 1u : 0u; mine = (j == x) ? c : mine; }
        if (sum == G) break;
        __builtin_amdgcn_s_sleep(1);
        if ((++sp & 255u) == 0u) { if (xb_ld(&bar[XB_TMO])) break; if (sp > XB_SPIN_CAP) { atomicAdd(&bar[XB_TMO], 1u); break; } }
    }
    nloc = mine > 0u ? mine : 1u; nx = cnt > 0u ? cnt : 1u;
}
__device__ __forceinline__ void xcd_barrier(const Ctx& F0) {
    const Ctx F = fresh(F0);
    asm volatile("s_waitcnt vmcnt(0)" ::: "memory");
    __syncthreads();
    if (F.tid == 0) {
        unsigned* bar = (unsigned*)(get_args()->ws + WS_CTL) + 1024;
        volatile LAS unsigned* st = (volatile LAS unsigned*)(F.lds + LDS_BYTES - 64);
        const unsigned x = xb_xcc_id();
        __builtin_amdgcn_s_waitcnt(0);
        unsigned nloc = st[0], nx = st[1];
        if (nloc == 0u) { xcd_barrier_complete(bar, x, (unsigned)F.G, nloc, nx); st[0] = nloc; st[1] = nx; }
        const unsigned old = xb_add(&bar[XB_XSUB(x)], 1u);
        const unsigned gen = old / nloc;
        if (old + 1u == (gen + 1u) * nloc) {
            __builtin_amdgcn_fence(__ATOMIC_RELEASE, "agent");
            asm volatile("s_waitcnt vmcnt(0)" ::: "memory");
            const unsigned og = xb_add(&bar[XB_TOP], 1u);
            const unsigned tg = og / nx;
            if (og + 1u == (tg + 1u) * nx) xb_add(&bar[XB_TOPGEN], 1u);
            else XB_SPIN(xb_ld(&bar[XB_TOPGEN]) == tg, bar);
            __builtin_amdgcn_fence(__ATOMIC_ACQUIRE, "agent");
            xb_add(&bar[XB_XGEN(x)], 1u);
            asm volatile("s_waitcnt vmcnt(0)" ::: "memory");
        } else {
            XB_SPIN(xb_ld(&bar[XB_XGEN(x)]) == gen, bar);
            __builtin_amdgcn_fence(__ATOMIC_ACQUIRE, "agent");
            asm volatile("s_waitcnt vmcnt(0)" ::: "memory");
        }
    }
    __syncthreads();
}

#define WSP(off) ((bf16_t*)(get_args()->ws + (off)))
__global__ void __launch_bounds__(512) fwd_kernel(Args args) {
    extern __shared__ __attribute__((aligned(16))) unsigned char lds_raw[];
    cg::grid_group grid = cg::this_grid();
    Ctx F; F.lds = (LAS unsigned char*)lds_raw; F.wave = __builtin_amdgcn_readfirstlane((int)(threadIdx.x >> 6));
    F.lane = (int)__builtin_amdgcn_mbcnt_hi(~0u, __builtin_amdgcn_mbcnt_lo(~0u, 0u)); F.tid = F.wave * 64 + F.lane;
    F.G = gridDim.x; F.bid = blockIdx.x;
    if (F.tid < 16) ((LAS unsigned*)(F.lds + LDS_BYTES - 64))[F.tid] = 0u;
    if (F.bid == 0) {
        unsigned* ctl = (unsigned*)(get_args()->ws + WS_CTL);
        for (int i = F.tid; i < 8192; i += 512) ctl[i] = 0u;
        __threadfence();
    }
    __syncthreads();
    grid.sync();
    if (F.tid == 0) (void)xb_add((unsigned*)(get_args()->ws + WS_CTL) + 1024 + XB_XCNT(xb_xcc_id()), 1u);
    __syncthreads();
#pragma unroll 1
    for (int ph = 0; ph < 25; ++ph) {
        const bool pro = (ph == 0); const int l = pro ? 0 : (ph - 1) / 12, k = pro ? -1 : (ph - 1) % 12;
        if (pro || (k == 11 && l == 0)) convert_weights(F, pro ? 0 : 1);
        if (pro || k == 5 || k == 8 || k == 11) {
            const int mode = pro ? 0 : (k == 8 ? 2 : 1);
            const float* gp = get_args()->in[k == 5 ? 33 : k == 8 ? 38 : 41] + l * D;
            row_pass(F, mode, l, WSP(WS_PROJ + OV_MIX), gp);
        } else if (k == 2) {
            rw_finish(F, l); hg_finish(F);
        } else if (k == 1) {
            rw_prepass(F, l);
            hg_pre(F, l);
            lru_pre(F, l);
            xcd_barrier(F);
            scan_phase(F, l);
        } else {
            size_t aoff = WS_XN, boff = W_IN, ooff = WS_PROJ, goff = WS_G2; int K = D, lda = D, ldb = D, N = NPROJ, mode = pg8::EP_STORE, ldc = NPROJ, three = 0;
            switch (k) {
                case 0: break;
                case 3: aoff = WS_BR; lda = NBR; boff = W_BR; ldb = 512; K = 512; N = D; three = 1; mode = pg8::EP_GATEACC; ooff = WS_PROJ + OV_S; ldc = D; break;
                case 4: aoff = WS_PROJ + OV_S; boff = W_OUT; N = D; ooff = WS_PROJ + OV_MIX; ldc = D; break;
                case 6: boff = W_GU; N = 2 * DFF; mode = pg8::EP_GLU; ooff = WS_PROJ + OV_HID; ldc = DFF; break;
                case 7: aoff = WS_PROJ + OV_HID; lda = DFF; boff = W_DN; ldb = DFF; K = DFF; N = D; ooff = WS_PROJ + OV_MIX; ldc = D; break;
                case 9: boff = W_PG; N = D; mode = pg8::EP_SIGMOID; ooff = WS_PROJ + OV_MIX; ldc = D; break;
                default: aoff = WS_PB; lda = PLE; boff = W_PLE; ldb = PLE; K = PLE; N = D; mode = pg8::EP_MULINPLACE; ooff = WS_PROJ + OV_MIX; ldc = D; break;
            }
            unsigned char* wsb = get_args()->ws;
            const bool n1024 = (N == D);
            if (n1024) sample_gemm(F, (const bf16_t*)(wsb + aoff), lda, (const bf16_t*)(wsb + WS_W + boff), K, mode, (bf16_t*)(wsb + ooff), (const bf16_t*)(wsb + goff), three);
            pg8::Gemm g{(const bf16_t*)(wsb + aoff), (const bf16_t*)(wsb + WS_W + boff), K, lda, ldb};
            pg8::Order S; S.init(n1024 ? MP : M, N, F.G, F.bid, three);
            pg8::Epi E{mode, (bf16_t*)(wsb + ooff), ldc, (const bf16_t*)(wsb + goff), NGATE};
            pg8::gemm_phase(F.lds, F.wave, g, S, E);
        }
        if (k != 9) xcd_barrier(F);
    }
}

extern "C" void kernel_launch(void* const* d_in, const int* in_sizes, int n_in, void* d_out, int out_size, void* d_ws, size_t ws_size, hipStream_t stream) {
    static int grid = 0;
    if (grid == 0) {
        if (n_in != 42 || out_size != (int)O_END || ws_size < WS_END) { fprintf(stderr, "kernel_launch: bad shapes: n_in %d out %d ws %zu (need %zu)\n", n_in, out_size, ws_size, (size_t)WS_END); grid = -1; return; }
        int dev = 0, cus = 0, per_cu = 0;
        (void)hipGetDevice(&dev); (void)hipDeviceGetAttribute(&cus, hipDeviceAttributeMultiprocessorCount, dev);
        (void)hipFuncSetAttribute((const void*)fwd_kernel, hipFuncAttributeMaxDynamicSharedMemorySize, LDS_BYTES);
        (void)hipOccupancyMaxActiveBlocksPerMultiprocessor(&per_cu, (const void*)fwd_kernel, 512, LDS_BYTES);
        if (per_cu < 1) per_cu = 1;
        grid = cus * per_cu; (void)hipGetLastError();
    }
    if (grid < 0) return;
    Args a{};
    for (int i = 0; i < 42; ++i) a.in[i] = (const float*)d_in[i];
    a.out = (float*)d_out; a.ws = (unsigned char*)d_ws;
    void* params[] = {&a};
    hipError_t e = hipLaunchCooperativeKernel((const void*)fwd_kernel, dim3(grid), dim3(512), params, LDS_BYTES, stream);
    if (e != hipSuccess) fprintf(stderr, "cooperative launch failed: %s (grid %d)\n", hipGetErrorString(e), grid);
}
```

```cpp
#include <hip/hip_runtime.h>
#include <hip/hip_cooperative_groups.h>
#include <cstdio>
#include <cstdint>
namespace cg = cooperative_groups;

#define LAS __attribute__((address_space(3)))
typedef unsigned short bf16_t;
typedef short bf16x8 __attribute__((ext_vector_type(8)));
typedef float f32x4 __attribute__((ext_vector_type(4)));
typedef unsigned u32x2 __attribute__((ext_vector_type(2)));
typedef unsigned u32x4 __attribute__((ext_vector_type(4)));

constexpr int D = 1024, MP = 16384, MS = 512, M = MP + MS, SEQ = 2048, NB = 8, NSB = 128, SSEQ = 4;
constexpr int NPROJ = 4864, NGATE = 3072, INC = 7936, DFF = 2816, RWC = 1792, PLE = 256, NBR = 1536;
constexpr int C_XA = 0, C_GA = 512, C_BQ = 1024, C_BF = 1536, C_BI = 2048, C_BG = 2560, C_CB = 3072;
constexpr float EPS = 1e-6f;
constexpr size_t O_Y = 0, O_CONVP = (size_t)M * D, O_LRUP = O_CONVP + 2 * 8 * 3 * 512, O_HGP = O_LRUP + 2 * 8 * 512,
                 O_RWP = O_HGP + 2 * 8 * 4 * 128 * 128, O_SHP = O_RWP + 2 * 8 * 8 * 64 * 64, O_CONVS = O_SHP + 2 * 8 * 1792,
                 O_LRUS = O_CONVS + 2 * 128 * 3 * 512, O_HGS = O_LRUS + 2 * 128 * 512, O_RWS = O_HGS + (size_t)2 * 128 * 4 * 128 * 128,
                 O_SHS = O_RWS + (size_t)2 * 128 * 8 * 64 * 64, O_END = O_SHS + 2 * 128 * 1792;
constexpr size_t MiB = 1u << 20;
constexpr size_t WS_CTL = 0;
constexpr size_t WS_W = 1 * MiB;
constexpr size_t W_IN = 0, W_BR = W_IN + (size_t)INC * D * 2, W_OUT = W_BR + (size_t)3072 * 512 * 2, W_GU = W_OUT + (size_t)D * D * 2,
                 W_DN = W_GU + (size_t)2 * DFF * D * 2, W_PLE = W_DN + (size_t)D * DFF * 2, W_PG = W_PLE + (size_t)D * PLE * 2,
                 W_WUP = W_PG + (size_t)D * D * 2, W_AUP = W_WUP + 512 * 64 * 2, W_GUP = W_AUP + 512 * 64 * 2, W_LWA = W_GUP + 512 * 128 * 2,
                 W_LWX = W_LWA + 8 * 64 * 64 * 2, W_END = W_LWX + 8 * 64 * 64 * 2;
constexpr size_t WS_XN = WS_W + 42 * MiB;
constexpr size_t WS_PROJ = WS_XN + (size_t)M * D * 2;
constexpr size_t WS_BR = WS_PROJ + (size_t)M * NPROJ * 2;
constexpr size_t WS_PB = WS_BR + (size_t)M * NBR * 2;
constexpr size_t WS_WEXP = WS_PB + (size_t)M * PLE * 2;
constexpr size_t WS_BON = WS_WEXP + (size_t)M * 512 * 2;
constexpr size_t WS_GG = WS_BON + (size_t)M * 512 * 2;
constexpr size_t WS_AV = WS_GG + (size_t)M * 512 * 2;
constexpr size_t WS_INV = WS_AV + (size_t)M * 512 * 2;
constexpr size_t WS_RKR = WS_INV + (size_t)M * 8 * 4;
constexpr size_t WS_HQS = WS_RKR + (size_t)M * 8 * 4;
constexpr size_t WS_HO1 = WS_HQS + (size_t)1024 * 64 * 128 * 2;
constexpr size_t WS_HKV = WS_HO1 + (size_t)1024 * 64 * 128 * 4;
constexpr size_t WS_HEB = WS_HKV + (size_t)1024 * 128 * 128 * 2;
constexpr size_t WS_HGG = WS_HEB + (size_t)1024 * 128 * 4;
constexpr size_t WS_LLA = WS_HGG + (size_t)MP * 512 * 2;
constexpr size_t WS_G2 = WS_LLA + (size_t)MP * 512 * 2;
constexpr size_t WS_END = WS_G2 + (size_t)M * NGATE * 2;
static_assert(WS_END <= ((size_t)608 << 20), "workspace budget");
static_assert(W_END <= 42 * MiB, "weights region");
constexpr size_t OV_G = 0;
constexpr size_t OV_S = (size_t)M * NGATE * 2;
constexpr size_t OV_MIX = 0;
constexpr size_t OV_HID = (size_t)M * D * 2;
static_assert(OV_S + (size_t)M * D * 2 <= (size_t)M * NPROJ * 2 && OV_HID + (size_t)M * DFF * 2 <= (size_t)M * NPROJ * 2, "overlay");

constexpr int LDS_BYTES = 147456;

__device__ __forceinline__ unsigned f2bf(float f) { unsigned u = __builtin_bit_cast(unsigned, f); return (u + 0x7fffu + ((u >> 16) & 1u)) >> 16; }
__device__ __forceinline__ float bf2f(unsigned h) { return __builtin_bit_cast(float, h << 16); }
typedef float f32x2_t __attribute__((ext_vector_type(2)));
typedef __bf16 bf16x2_t __attribute__((ext_vector_type(2)));
__device__ __forceinline__ unsigned pk2(float lo, float hi) { const f32x2_t v = {lo, hi}; const bf16x2_t b = __builtin_convertvector(v, bf16x2_t); return __builtin_bit_cast(unsigned, b); }
__device__ __forceinline__ float sigmoidf_(float x) { return __builtin_amdgcn_rcpf(1.f + __expf(-x)); }
__device__ __forceinline__ float siluf_(float x) { return x * __builtin_amdgcn_rcpf(1.f + __expf(-x)); }
__device__ __forceinline__ float softplusf_(float x) { return fmaxf(x, 0.f) + log1pf(__expf(-fabsf(x))); }
__device__ __forceinline__ float gelu_tanh(float x) { const float u = 0.7978845608028654f * (x + 0.044715f * x * x * x); return x * sigmoidf_(2.f * u); }
__device__ __forceinline__ float tanh_fast(float x) { return 2.f * sigmoidf_(2.f * x) - 1.f; }
__device__ __forceinline__ float wave_sum(float v) {
#pragma unroll
    for (int o = 1; o < 64; o <<= 1) v += __shfl_xor(v, o);
    return v;
}
#define DPP_ADD(v, ctrl) ((v) + __builtin_bit_cast(float, __builtin_amdgcn_update_dpp(0, __builtin_bit_cast(int, (v)), (ctrl), 0xf, 0xf, false)))
__device__ __forceinline__ float row16_sum(float v) {
    v = DPP_ADD(v, 0xB1); v = DPP_ADD(v, 0x4E); v = DPP_ADD(v, 0x141); v = DPP_ADD(v, 0x140); return v;
}
__device__ __forceinline__ float wave_sum_l63(float v) {
    v = row16_sum(v);
    v += __builtin_bit_cast(float, __builtin_amdgcn_update_dpp(0, __builtin_bit_cast(int, v), 0x142, 0xa, 0xf, false));
    v += __builtin_bit_cast(float, __builtin_amdgcn_update_dpp(0, __builtin_bit_cast(int, v), 0x143, 0xc, 0xf, false));
    return v;
}
__device__ __forceinline__ float wave_sum_all(float v) {
    v = row16_sum(v); v += __shfl_xor(v, 16); v += __shfl_xor(v, 32); return v;
}
#define LDS_WAIT() asm volatile("s_waitcnt lgkmcnt(0)" ::: "memory")

namespace pg8 {
enum { EP_STORE = 0, EP_SIGMOID = 1, EP_MULINPLACE = 2, EP_GLU = 3, EP_GATEACC = 4 };
constexpr int BM = 256, BK = 64, HALF = 128, HTB = HALF * BK * 2, STAGE_BYTES = 8 * HTB, NXCD = 8, WGM = 8;
__host__ __device__ __forceinline__ int lds_byte(int r, int c) { const int st = (r >> 4) * 2 + (c >> 5), rr = r & 15, cc = c & 31, ob = rr * 64 + cc * 2; return st * 1024 + (ob ^ (((ob >> 9) & 1) << 5)); }
__host__ __device__ __forceinline__ void stage_rc(int b, int& R, int& C) { const int st = b / 1024, sb = b % 1024, swz = sb ^ (((sb >> 9) & 1) << 5); R = (st >> 1) * 16 + swz / 64; C = (st & 1) * 32 + (swz % 64) / 2; }
__host__ __device__ __forceinline__ int perm32(int rho) { const int n = rho >> 4, i = rho & 15; return 8 * (i >> 2) + 4 * n + (i & 3); }
struct Unit { int pm, pn, ak; };
struct Gemm { const bf16_t* A; const bf16_t* Bt; int K, lda, ldb; };
struct StaticOrder {
    int nM, nN, nwg, G, c;
    __device__ void init(int M_, int N_, int G_, int c_) { nM = M_ / BM; nN = N_ / BM; nwg = nM * nN; G = G_; c = c_; }
    __device__ bool next(int i, Unit& u) const {
        const long L = (long)i * G + c; if (L >= nwg) return false;
        int wgid = (int)L; { const int q = nwg / NXCD, r = nwg % NXCD, xcd = wgid % NXCD, off = wgid / NXCD; wgid = (xcd < r ? xcd * (q + 1) : r * (q + 1) + (xcd - r) * q) + off; }
        const int nig = WGM * nN, gid = wgid / nig, fm = gid * WGM, gsz = (nM - fm) < WGM ? (nM - fm) : WGM;
        u.pm = fm + ((wgid % nig) % gsz); u.pn = (wgid % nig) / gsz; u.ak = 0; return true;
    }
};
struct Order {
    StaticOrder b; int three;
    __device__ void init(int M_, int N_, int G_, int c_, int three_) { b.init(M_, N_, G_, c_); three = three_; }
    __device__ bool next(int i, Unit& u) const {
        if (!three) return b.next(i, u);
        Unit t; if (!b.next(i / 3, t)) return false; const int n = i % 3;
        u.pm = t.pm; u.pn = n * 4 + t.pn; u.ak = n * 512; return true;
    }
};

template <class Epi, class Sched>
__device__ __forceinline__ void gemm_phase(LAS unsigned char* lds, int wid, const Gemm g, const Sched& S, const Epi& E) {
    int lane_ = (int)__builtin_amdgcn_mbcnt_hi(~0u, __builtin_amdgcn_mbcnt_lo(~0u, 0u)); asm volatile("" : "+v"(lane_));
    const int lane = lane_, tid = wid * 64 + lane, wr = wid >> 2, wc = wid & 3, fr = lane & 15, fq = lane >> 4;
    const int K = g.K, nt = K / BK;
    unsigned voffA[2], voffB[2];
#pragma unroll
    for (int i = 0; i < 2; ++i) { int R, C; stage_rc(tid * 16 + i * 8192, R, C); const int Rb = (E.mode != EP_GLU) ? ((R & ~31) + perm32(R & 31)) : R;
        voffA[i] = (unsigned)(R * g.lda + C) * 2u; voffB[i] = (unsigned)(Rb * g.ldb + C) * 2u; }
    const size_t kstep = (size_t)(BK * 2);
    const size_t hstepA = (size_t)HALF * g.lda * 2, hstepB = (size_t)HALF * g.ldb * 2;
    const size_t tstepA = 2 * hstepA, tstepB = 2 * hstepB;
    const unsigned ldsw = (unsigned)wid * 1024u;
    const int aoff = lds_byte(wr * 64 + fr, fq * 8), boff = lds_byte(wc * 32 + fr, fq * 8);
#define PG8_SA(b, h) (((b) * 2 + (h)) * HTB)
#define PG8_SB(b, h) ((4 + (b) * 2 + (h)) * HTB)
#define PG8_STAGE(bufoff, gbase, voff) do { _Pragma("unroll") for (int _i = 0; _i < 2; ++_i) \
        __builtin_amdgcn_global_load_lds((const unsigned*)((const char*)(gbase) + (voff)[_i]), (LAS unsigned*)(lds + (bufoff) + ldsw + _i * 8192), 16, 0, 0); } while (0)
#define PG8_LDA(dst, b, h) do { _Pragma("unroll") for (int m = 0; m < 4; ++m) _Pragma("unroll") for (int k = 0; k < 2; ++k) dst[m][k] = *(const LAS bf16x8*)(lds + PG8_SA(b, h) + aoff + m * 2048 + k * 1024); } while (0)
#define PG8_LDB(dst, b, h) do { _Pragma("unroll") for (int n = 0; n < 2; ++n) _Pragma("unroll") for (int k = 0; k < 2; ++k) dst[n][k] = *(const LAS bf16x8*)(lds + PG8_SB(b, h) + boff + n * 2048 + k * 1024); } while (0)
#define PG8_MMA(ai, bj, At, Bt) do { __builtin_amdgcn_s_setprio(1); _Pragma("unroll") for (int m = 0; m < 4; ++m) _Pragma("unroll") for (int n = 0; n < 2; ++n) _Pragma("unroll") for (int k = 0; k < 2; ++k) \
        acc[ai][bj][m][n] = __builtin_amdgcn_mfma_f32_16x16x32_bf16(Bt[n][k], At[m][k], acc[ai][bj][m][n], 0, 0, 0); __builtin_amdgcn_s_setprio(0); } while (0)
#define PG8_WAIT_V(n) asm volatile("s_waitcnt vmcnt(" #n ")" ::: "memory")
#define PG8_WAIT_L(n) asm volatile("s_waitcnt lgkmcnt(" #n ")" ::: "memory")
#define PG8_BAR __builtin_amdgcn_s_barrier()
#define PG8_SCHED __builtin_amdgcn_sched_barrier(0)
    Unit cur, nxt; int ui = 0;
    if (!S.next(0, cur)) return;
    f32x4 acc[2][2][4][2];
#pragma unroll
    for (int a = 0; a < 2; ++a)
#pragma unroll
        for (int b = 0; b < 2; ++b)
#pragma unroll
            for (int m = 0; m < 4; ++m)
#pragma unroll
                for (int n = 0; n < 2; ++n) acc[a][b][m][n] = (f32x4){0.f, 0.f, 0.f, 0.f};
    bf16x8 At[4][2], B0[2][2], B1[2][2];
    const char* cA = (const char*)g.A + (size_t)cur.pm * tstepA + (size_t)cur.ak * 2; const char* cB = (const char*)g.Bt + (size_t)cur.pn * tstepB;
    PG8_STAGE(PG8_SB(0, 0), cB, voffB); PG8_STAGE(PG8_SB(0, 1), cB + hstepB, voffB); PG8_STAGE(PG8_SA(0, 0), cA, voffA); PG8_STAGE(PG8_SA(0, 1), cA + hstepA, voffA);
    if (wr == 1) PG8_BAR;
    PG8_WAIT_V(2); PG8_BAR;
    PG8_STAGE(PG8_SB(1, 0), cB + kstep, voffB); PG8_STAGE(PG8_SA(1, 0), cA + kstep, voffA); PG8_STAGE(PG8_SB(1, 1), cB + hstepB + kstep, voffB);
    PG8_WAIT_V(6); PG8_BAR;
    for (;;) {
        const bool has_next = S.next(ui + 1, nxt);
        const char* nA = has_next ? (const char*)g.A + (size_t)nxt.pm * tstepA + (size_t)nxt.ak * 2 : cA; const char* nB = has_next ? (const char*)g.Bt + (size_t)nxt.pn * tstepB : cB;
        for (int t = 0; t < nt; t += 2) {
            const bool last = (t == nt - 2);
            const char* a1 = cA + (size_t)(t + 1) * kstep;
            const char* a2 = last ? nA : cA + (size_t)(t + 2) * kstep; const char* b2 = last ? nB : cB + (size_t)(t + 2) * kstep;
            const char* a3 = a2 + kstep; const char* b3 = b2 + kstep;
            PG8_LDB(B0, 0, 0); PG8_LDB(B1, 0, 1); PG8_SCHED; PG8_LDA(At, 0, 0); PG8_STAGE(PG8_SA(1, 1), a1 + hstepA, voffA);
            PG8_WAIT_V(8); PG8_WAIT_L(0); PG8_BAR; PG8_MMA(0, 0, At, B0); PG8_MMA(0, 1, At, B1); PG8_BAR; PG8_SCHED;
            PG8_LDA(At, 0, 1); PG8_STAGE(PG8_SB(0, 0), b2, voffB); PG8_STAGE(PG8_SB(0, 1), b2 + hstepB, voffB); PG8_STAGE(PG8_SA(0, 0), a2, voffA);
            PG8_WAIT_V(8); PG8_WAIT_L(0); PG8_BAR; PG8_MMA(1, 0, At, B0); PG8_MMA(1, 1, At, B1); PG8_BAR; PG8_SCHED;
            PG8_LDB(B0, 1, 0); PG8_LDB(B1, 1, 1); PG8_SCHED; PG8_LDA(At, 1, 0); PG8_STAGE(PG8_SA(0, 1), a2 + hstepA, voffA);
            PG8_WAIT_V(8); PG8_WAIT_L(0); PG8_BAR; PG8_MMA(0, 0, At, B0); PG8_MMA(0, 1, At, B1); PG8_BAR; PG8_SCHED;
            PG8_LDA(At, 1, 1); PG8_STAGE(PG8_SB(1, 0), b3, voffB); PG8_STAGE(PG8_SB(1, 1), b3 + hstepB, voffB); PG8_STAGE(PG8_SA(1, 0), a3, voffA);
            PG8_WAIT_V(8); PG8_WAIT_L(0); PG8_BAR; PG8_MMA(1, 0, At, B0); PG8_MMA(1, 1, At, B1); PG8_BAR; PG8_SCHED;
        }
        if (wr == 0) PG8_BAR;
        E(acc, cur, wr, wc, fr, fq);
        if (!has_next) break;
#pragma unroll
        for (int a = 0; a < 2; ++a)
#pragma unroll
            for (int b = 0; b < 2; ++b)
#pragma unroll
                for (int m = 0; m < 4; ++m)
#pragma unroll
                    for (int n = 0; n < 2; ++n) acc[a][b][m][n] = (f32x4){0.f, 0.f, 0.f, 0.f};
        cur = nxt; cA = nA; cB = nB; ++ui;
        if (wr == 1) PG8_BAR;
    }
    PG8_WAIT_V(0);
    PG8_BAR;
#undef PG8_SA
#undef PG8_SB
#undef PG8_STAGE
#undef PG8_LDA
#undef PG8_LDB
#undef PG8_MMA
#undef PG8_WAIT_V
#undef PG8_WAIT_L
#undef PG8_BAR
#undef PG8_SCHED
}

__device__ __forceinline__ void st4(bf16_t* p, f32x4 v) { u32x2 w; w.x = pk2(v[0], v[1]); w.y = pk2(v[2], v[3]); *(u32x2*)p = w; }
__device__ __forceinline__ f32x4 ld4(const bf16_t* p) { const u32x2 w = *(const u32x2*)p; return (f32x4){bf2f(w.x & 0xffffu), bf2f(w.x >> 16), bf2f(w.y & 0xffffu), bf2f(w.y >> 16)}; }
__device__ __forceinline__ void st8(bf16_t* p, f32x4 a, f32x4 b) { u32x4 w; w.x = pk2(a[0], a[1]); w.y = pk2(a[2], a[3]); w.z = pk2(b[0], b[1]); w.w = pk2(b[2], b[3]); *(u32x4*)p = w; }
__device__ __forceinline__ void ld8(const bf16_t* p, f32x4& a, f32x4& b) { const u32x4 w = *(const u32x4*)p; a = (f32x4){bf2f(w.x & 0xffffu), bf2f(w.x >> 16), bf2f(w.y & 0xffffu), bf2f(w.y >> 16)}; b = (f32x4){bf2f(w.z & 0xffffu), bf2f(w.z >> 16), bf2f(w.w & 0xffffu), bf2f(w.w >> 16)}; }
struct Epi {
    int mode; bf16_t* O; int ldc; const bf16_t* G; int ldg;
    __device__ __forceinline__ void operator()(const f32x4 (&acc)[2][2][4][2], const Unit& u, int wr, int wc, int fr, int fq) const {
        const int row0 = u.pm * BM + wr * 64 + fr;
        if (mode == EP_GLU) {
#pragma unroll
            for (int ai = 0; ai < 2; ++ai)
#pragma unroll
                for (int m = 0; m < 4; ++m) {
                    bf16_t* rp = O + (size_t)(row0 + ai * HALF + m * 16) * ldc + u.pn * 128 + wc * 16 + 4 * fq;
#pragma unroll
                    for (int bj = 0; bj < 2; ++bj) {
                        const f32x4 gt = acc[ai][bj][m][0], up = acc[ai][bj][m][1]; f32x4 v;
#pragma unroll
                        for (int j = 0; j < 4; ++j) v[j] = siluf_(gt[j]) * up[j];
                        st4(rp + bj * 64, v);
                    }
                }
        } else if (mode == EP_GATEACC) {
            const int nb = u.pn >> 2, colb = (u.pn & 3) * BM + wc * 32 + 8 * fq;
#pragma unroll
            for (int ai = 0; ai < 2; ++ai)
#pragma unroll
                for (int m = 0; m < 4; ++m) {
                    const size_t row = (size_t)(row0 + ai * HALF + m * 16);
                    bf16_t* rp = O + row * ldc + colb; const bf16_t* gp = G + row * ldg + nb * 1024 + colb;
#pragma unroll
                    for (int bj = 0; bj < 2; ++bj) {
                        f32x4 g0, g1; ld8(gp + bj * HALF, g0, g1);
                        f32x4 v0 = acc[ai][bj][m][0] * g0, v1 = acc[ai][bj][m][1] * g1;
                        if (nb > 0) { f32x4 p0, p1; ld8(rp + bj * HALF, p0, p1); v0 = v0 + p0; v1 = v1 + p1; }
                        st8(rp + bj * HALF, v0, v1);
                    }
                }
        } else {
#pragma unroll
            for (int ai = 0; ai < 2; ++ai)
#pragma unroll
                for (int m = 0; m < 4; ++m) {
                    bf16_t* rp = O + (size_t)(row0 + ai * HALF + m * 16) * ldc + u.pn * BM + wc * 32 + 8 * fq;
#pragma unroll
                    for (int bj = 0; bj < 2; ++bj) {
                        f32x4 v0 = acc[ai][bj][m][0], v1 = acc[ai][bj][m][1];
                        if (mode == EP_SIGMOID) {
#pragma unroll
                            for (int j = 0; j < 4; ++j) { v0[j] = sigmoidf_(v0[j]); v1[j] = sigmoidf_(v1[j]); }
                        }
                        if (mode == EP_MULINPLACE) { f32x4 p0, p1; ld8(rp + bj * HALF, p0, p1); v0 = v0 * p0; v1 = v1 * p1; }
                        st8(rp + bj * HALF, v0, v1);
                    }
                }
        }
    }
};
}

struct Args { const float* in[42]; float* out; unsigned char* ws; };
typedef const __attribute__((address_space(4))) Args* CArgs;
__device__ __forceinline__ CArgs get_args() { CArgs p = (CArgs)__builtin_amdgcn_kernarg_segment_ptr(); asm volatile("" : "+s"(p)); return p; }

struct Ctx {
    LAS unsigned char* lds; int tid, lane, wave, G, bid;
};
__device__ __forceinline__ Ctx fresh(const Ctx& F0) { Ctx F = F0; int t = (int)__builtin_amdgcn_mbcnt_hi(~0u, __builtin_amdgcn_mbcnt_lo(~0u, 0u)); asm volatile("" : "+v"(t)); F.lane = t; F.tid = F0.wave * 64 + t; return F; }

__device__ __forceinline__ void tr_item(const float* W, int K, int N, bf16_t* WT, int row_off, const float* gain, int rmap, LAS float* scr, int item, int lane) {
    const int nblk = N / 32, kb = item / nblk, nb = item % nblk, k0 = 64 * kb, n0 = 32 * nb;
#pragma unroll 8
    for (int i = 0; i < 32; ++i) { const int kk = 2 * i + (lane >> 5); const float gsc = gain ? gain[k0 + kk] : 1.f; scr[kk * 33 + (lane & 31)] = W[(size_t)(k0 + kk) * N + n0 + (lane & 31)] * gsc; }
    LDS_WAIT(); asm volatile("" ::: "memory");
    const int c = lane & 7;
#pragma unroll
    for (int j = 0; j < 4; ++j) { const int n = (lane >> 3) + 8 * j; const LAS float* s = scr + (8 * c) * 33 + n;
        u32x4 o; o.x = pk2(s[0 * 33], s[1 * 33]); o.y = pk2(s[2 * 33], s[3 * 33]); o.z = pk2(s[4 * 33], s[5 * 33]); o.w = pk2(s[6 * 33], s[7 * 33]);
        const int ng = n0 + n; const int orow = rmap == 0 ? row_off + ng : (32 * (ng >> 4) + (ng & 15) + (rmap == 2 ? 16 : 0));
        *(u32x4*)(WT + (size_t)orow * K + k0 + 8 * c) = o; }
    LDS_WAIT(); asm volatile("" ::: "memory");
}

__device__ __forceinline__ void convert_weights(const Ctx& F0, int l) {
    const Ctx F = fresh(F0);
    CArgs a = get_args(); unsigned char* wb = a->ws + WS_W;
    LAS float* scr = (LAS float*)(F.lds + F.wave * 16384);
    const int gw = F.bid * 8 + F.wave, NGW = F.G * 8;
    constexpr int I_IN = 16 * (INC / 32), I_BR = 8 * 32, I_OUT = 16 * 32, I_G = 16 * (DFF / 32), I_DN = (DFF / 64) * 32, I_PLE = 4 * 32, I_PG = 16 * 32, I_UP = 16, I_GUP = 32, I_L = 2;
    constexpr int NIT = I_IN + 3 * I_BR + I_OUT + 2 * I_G + I_DN + I_PLE + I_PG + 2 * I_UP + I_GUP + 16 * I_L;
    for (int it = gw; it < NIT; it += NGW) {
        int r = it; const float* W; int K, N, row_off = 0, rmap = 0, widx; size_t woff, wtoff; const float* gain = nullptr;
        if (r < I_IN) { widx = 10; woff = (size_t)l * D * INC; K = D; N = INC; wtoff = W_IN; gain = a->in[9] + l * D; }
        else if ((r -= I_IN) < 3 * I_BR) { const int n = r / I_BR; r %= I_BR; widx = 31; woff = ((size_t)l * 3 + n) * 512 * D; K = 512; N = D; wtoff = W_BR; row_off = n * 1024; }
        else if ((r -= 3 * I_BR) < I_OUT) { widx = 32; woff = (size_t)l * D * D; K = D; N = D; wtoff = W_OUT; }
        else if ((r -= I_OUT) < I_G) { widx = 35; woff = (size_t)l * D * DFF; K = D; N = DFF; wtoff = W_GU; gain = a->in[34] + l * D; rmap = 1; }
        else if ((r -= I_G) < I_G) { widx = 36; woff = (size_t)l * D * DFF; K = D; N = DFF; wtoff = W_GU; gain = a->in[34] + l * D; rmap = 2; }
        else if ((r -= I_G) < I_DN) { widx = 37; woff = (size_t)l * DFF * D; K = DFF; N = D; wtoff = W_DN; }
        else if ((r -= I_DN) < I_PLE) { widx = 39; woff = (size_t)l * PLE * D; K = PLE; N = D; wtoff = W_PLE; }
        else if ((r -= I_PLE) < I_PG) { widx = 40; woff = (size_t)l * D * D; K = D; N = D; wtoff = W_PG; }
        else if ((r -= I_PG) < I_UP) { widx = 22; woff = (size_t)l * 64 * 512; K = 64; N = 512; wtoff = W_WUP; }
        else if ((r -= I_UP) < I_UP) { widx = 24; woff = (size_t)l * 64 * 512; K = 64; N = 512; wtoff = W_AUP; }
        else if ((r -= I_UP) < I_GUP) { widx = 25; woff = (size_t)l * 128 * 512; K = 128; N = 512; wtoff = W_GUP; }
        else if ((r -= I_GUP) < 8 * I_L) { const int blk = r / I_L; r %= I_L; widx = 13; woff = ((size_t)l * 8 + blk) * 4096; K = 64; N = 64; wtoff = W_LWA + (size_t)blk * 8192; }
        else { r -= 8 * I_L; const int blk = r / I_L; r %= I_L; widx = 15; woff = ((size_t)l * 8 + blk) * 4096; K = 64; N = 64; wtoff = W_LWX + (size_t)blk * 8192; }
        W = a->in[widx] + woff;
        tr_item(W, K, N, (bf16_t*)(wb + wtoff), row_off, gain, rmap, scr, r, F.lane);
    }
}

__device__ __forceinline__ void row_pass(const Ctx& F0, int mode, int l, const bf16_t* Y, const float* gpost, bool wr_xn) {
    const Ctx F = fresh(F0);
    CArgs a = get_args();
    float* X = a->out; bf16_t* XN = (bf16_t*)(a->ws + WS_XN);
    const int gw = F.bid * 8 + F.wave, NGW = F.G * 8, lane = F.lane;
    for (int m = gw; m < M; m += NGW) {
        f32x4 v[4];
        if (mode == 0) {
            const float* xr = (m < MP) ? a->in[0] + (size_t)m * D : a->in[1] + (size_t)(m - MP) * D;
#pragma unroll
            for (int j = 0; j < 4; ++j) v[j] = __builtin_nontemporal_load((const f32x4*)(xr + j * 256 + lane * 4));
        } else {
            f32x4 y[4]; float s = 0.f;
#pragma unroll
            for (int j = 0; j < 4; ++j) { { const u32x2 yw = __builtin_nontemporal_load((const u32x2*)(Y + (size_t)m * D + j * 256 + lane * 4)); y[j] = (f32x4){bf2f(yw.x & 0xffffu), bf2f(yw.x >> 16), bf2f(yw.y & 0xffffu), bf2f(yw.y >> 16)}; } s += y[j][0] * y[j][0] + y[j][1] * y[j][1] + y[j][2] * y[j][2] + y[j][3] * y[j][3]; }
            const float rs = rsqrtf(wave_sum(s) * (1.f / D) + EPS);
#pragma unroll
            for (int j = 0; j < 4; ++j) { const f32x4 gq = *(const f32x4*)(gpost + j * 256 + lane * 4); const f32x4 xv = __builtin_nontemporal_load((const f32x4*)(X + (size_t)m * D + j * 256 + lane * 4)); v[j] = xv + y[j] * rs * gq; }
        }
        float s2 = 0.f;
#pragma unroll
        for (int j = 0; j < 4; ++j) s2 += v[j][0] * v[j][0] + v[j][1] * v[j][1] + v[j][2] * v[j][2] + v[j][3] * v[j][3];
        const float r2 = (mode == 2) ? 1.f : rsqrtf(wave_sum(s2) * (1.f / D) + EPS);
#pragma unroll
        for (int j = 0; j < 4; ++j) { __builtin_nontemporal_store(v[j], (f32x4*)(X + (size_t)m * D + j * 256 + lane * 4)); if (wr_xn) pg8::st4(XN + (size_t)m * D + j * 256 + lane * 4, v[j] * r2); }
        if (mode == 2) {
            const float* pr = (m < MP) ? a->in[2] + ((size_t)l * MP + m) * PLE : a->in[3] + ((size_t)l * MS + (m - MP)) * PLE;
            const f32x4 pv = *(const f32x4*)(pr + lane * 4);
            pg8::st4((bf16_t*)(a->ws + WS_PB) + (size_t)m * PLE + lane * 4, pv);
        }
    }
}

__device__ __forceinline__ void rw_finish(const Ctx& F0, int l) {
    const Ctx F = fresh(F0);
    CArgs a = get_args();
    const bf16_t* BO = (const bf16_t*)(a->ws + WS_BON); const bf16_t* GGp = (const bf16_t*)(a->ws + WS_GG);
    bf16_t* BR = (bf16_t*)(a->ws + WS_BR);
    const float* lng = a->in[29] + l * 512; const float* lnb = a->in[30] + l * 512;
    const int gw = F.bid * 8 + F.wave, NGW = F.G * 8, lane = F.lane;
    for (int it0 = gw * 4; it0 < M * 8; it0 += NGW * 4) {
        float o[4], bo[4], gg[4]; bf16_t* op[4];
#pragma unroll
        for (int q = 0; q < 4; ++q) { const int it = it0 + q, m = it >> 3, h = it & 7; const size_t idx = (size_t)m * 512 + h * 64 + lane; op[q] = BR + (size_t)m * NBR + 1024 + h * 64 + lane;
            o[q] = bf2f(*op[q]); bo[q] = bf2f(BO[idx]); gg[q] = bf2f(GGp[idx]); }
#pragma unroll
        for (int q = 0; q < 4; ++q) { const int h = (it0 + q) & 7;
            const float mean = wave_sum_all(o[q]) * (1.f / 64.f); const float dlt = o[q] - mean;
            const float var = wave_sum_all(dlt * dlt) * (1.f / 64.f);
            const float y = (dlt * rsqrtf(var + 64e-5f) * lng[h * 64 + lane] + lnb[h * 64 + lane] + bo[q]) * gg[q];
            *op[q] = (bf16_t)f2bf(y); }
    }
}

__device__ __forceinline__ void st4l(LAS bf16_t* p, f32x4 v) { u32x2 w; w.x = pk2(v[0], v[1]); w.y = pk2(v[2], v[3]); *(LAS u32x2*)p = w; }

__device__ __forceinline__ void rw_prepass(const Ctx& F0, int l) {
    const Ctx F = fresh(F0);
    CArgs a = get_args(); const int tid = F.tid, lane = F.lane, wave = F.wave, fr = lane & 15, fq = lane >> 4, h = wave;
    const bf16_t* PROJ = (const bf16_t*)(a->ws + WS_PROJ);
    bf16_t* WEXP = (bf16_t*)(a->ws + WS_WEXP); bf16_t* AVp = (bf16_t*)(a->ws + WS_AV); bf16_t* GGp = (bf16_t*)(a->ws + WS_GG);
    float* INV = (float*)(a->ws + WS_INV); float* RKR = (float*)(a->ws + WS_RKR);
    LAS bf16_t* ATANH = (LAS bf16_t*)F.lds;
    LAS bf16_t* AAL = ATANH + 32 * 72;
    LAS bf16_t* ASG = AAL + 32 * 72;
    LAS float* ALDS = (LAS float*)(ASG + 32 * 136) + wave * 2048;
    const float* mu = a->in[20] + l * RWC; const float* shs = a->in[8] + (size_t)l * NSB * RWC;
    const int ch = l * 512 + h * 64 + lane;
    const float c_kk = a->in[26][ch], c_ka = a->in[27][ch], c_rk = a->in[28][ch], mu_r = mu[h * 64 + lane], mu_k = mu[512 + h * 64 + lane];
    const bf16_t* wupT = (const bf16_t*)(a->ws + WS_W + W_WUP); const bf16_t* aupT = (const bf16_t*)(a->ws + WS_W + W_AUP); const bf16_t* gupT = (const bf16_t*)(a->ws + WS_W + W_GUP);
    for (int u = F.bid; u < M / 32; u += F.G) {
        const int m0 = u * 32;
        unsigned rkraw[16], rkraw2[16];
        { const bf16_t* prq = PROJ + (size_t)m0 * NPROJ + C_CB + h * 64 + lane;
#pragma unroll
          for (int t = 0; t < 16; ++t) rkraw[t] = (unsigned)prq[(size_t)t * NPROJ] | ((unsigned)prq[(size_t)t * NPROJ + 512] << 16); }
        __syncthreads();
        {
            const int tok = tid >> 4, c0 = (tid & 15) * 16, m = m0 + tok;
            const bf16_t* pc = PROJ + (size_t)m * NPROJ + C_CB + 1536 + c0;
            const bool first = (m < MP) ? ((m & (SEQ - 1)) == 0) : (((m - MP) & 3) == 0);
#pragma unroll
            for (int i = 0; i < 4; ++i) {
                const f32x4 cur = pg8::ld4(pc + i * 4); f32x4 prev;
                if (!first) prev = pg8::ld4(pc - NPROJ + i * 4);
                else if (m >= MP) prev = *(const f32x4*)(shs + (size_t)((m - MP) >> 2) * RWC + 1536 + c0 + i * 4);
                else prev = (f32x4){0.f, 0.f, 0.f, 0.f};
                const f32x4 mq = *(const f32x4*)(mu + 1536 + c0 + i * 4);
                f32x4 xm = cur + (prev - cur) * mq;
                const int cc = c0 + i * 4;
                if (cc < 64) {
#pragma unroll
                    for (int j = 0; j < 4; ++j) xm[j] = tanh_fast(xm[j]);
                    st4l(ATANH + tok * 72 + cc, xm);
                } else if (cc < 128) st4l(AAL + tok * 72 + cc - 64, xm);
                else {
#pragma unroll
                    for (int j = 0; j < 4; ++j) xm[j] = sigmoidf_(xm[j]);
                    st4l(ASG + tok * 136 + cc - 128, xm);
                }
            }
        }
        __syncthreads();
#define RWP_LOADF(X, nt_) do { const int col_ = h * 64 + (nt_) * 16 + fr; \
            X##w0 = *(const bf16x8*)(wupT + (size_t)col_ * 64 + fq * 8); X##w1 = *(const bf16x8*)(wupT + (size_t)col_ * 64 + 32 + fq * 8); \
            X##a0 = *(const bf16x8*)(aupT + (size_t)col_ * 64 + fq * 8); X##a1 = *(const bf16x8*)(aupT + (size_t)col_ * 64 + 32 + fq * 8); \
            _Pragma("unroll") for (int ks = 0; ks < 4; ++ks) X##g[ks] = *(const bf16x8*)(gupT + (size_t)col_ * 128 + ks * 32 + fq * 8); \
            X##c0 = a->in[21][l * 512 + col_]; X##c1 = a->in[23][l * 512 + col_]; } while (0)
        bf16x8 Nw0, Nw1, Na0, Na1, Ng[4]; float Nc0, Nc1;
        RWP_LOADF(N, 0);
#pragma unroll
        for (int nt = 0; nt < 4; ++nt) {
            const int col = h * 64 + nt * 16 + fr;
            const bf16x8 bw0 = Nw0, bw1 = Nw1, ba0 = Na0, ba1 = Na1; bf16x8 bg[4];
#pragma unroll
            for (int ks = 0; ks < 4; ++ks) bg[ks] = Ng[ks];
            const float w0 = Nc0, a0 = Nc1;
            if (nt < 3) RWP_LOADF(N, nt + 1);
#pragma unroll
            for (int mt = 0; mt < 2; ++mt) {
                f32x4 cw = (f32x4){0.f, 0.f, 0.f, 0.f}, ca = cw, cgv = cw;
                const LAS bf16_t* At = ATANH + (mt * 16 + fr) * 72 + fq * 8; const LAS bf16_t* Aa = AAL + (mt * 16 + fr) * 72 + fq * 8; const LAS bf16_t* Ag = ASG + (mt * 16 + fr) * 136 + fq * 8;
                cw = __builtin_amdgcn_mfma_f32_16x16x32_bf16(*(const LAS bf16x8*)(At), bw0, cw, 0, 0, 0);
                cw = __builtin_amdgcn_mfma_f32_16x16x32_bf16(*(const LAS bf16x8*)(At + 32), bw1, cw, 0, 0, 0);
                ca = __builtin_amdgcn_mfma_f32_16x16x32_bf16(*(const LAS bf16x8*)(Aa), ba0, ca, 0, 0, 0);
                ca = __builtin_amdgcn_mfma_f32_16x16x32_bf16(*(const LAS bf16x8*)(Aa + 32), ba1, ca, 0, 0, 0);
#pragma unroll
                for (int ks = 0; ks < 4; ++ks) cgv = __builtin_amdgcn_mfma_f32_16x16x32_bf16(*(const LAS bf16x8*)(Ag + ks * 32), bg[ks], cgv, 0, 0, 0);
#pragma unroll
                for (int j = 0; j < 4; ++j) {
                    const int tok = mt * 16 + fq * 4 + j; const size_t o = (size_t)(m0 + tok) * 512 + col;
                    const float wv = -softplusf_(-(w0 + cw[j])) - 0.5f;
                    WEXP[o] = (bf16_t)f2bf(-__expf(wv));
                    const unsigned ab = f2bf(sigmoidf_(a0 + ca[j]));
                    AVp[o] = (bf16_t)ab; ALDS[tok * 64 + nt * 16 + fr] = bf2f(ab);
                    GGp[o] = (bf16_t)f2bf(cgv[j]);
                }
            }
        }
        LDS_WAIT();
        {
            const bf16_t* pr = PROJ + (size_t)m0 * NPROJ + C_CB + h * 64 + lane;
            float rprev, kprev;
            {
                const bool first0 = (m0 < MP) ? ((m0 & (SEQ - 1)) == 0) : true;
                if (!first0) { rprev = bf2f(*(pr - NPROJ)); kprev = bf2f(*(pr - NPROJ + 512)); }
                else if (m0 >= MP) { const float* sp = shs + (size_t)((m0 - MP) >> 2) * RWC + h * 64 + lane; rprev = sp[0]; kprev = sp[512]; }
                else { rprev = 0.f; kprev = 0.f; }
            }
#pragma unroll
            for (int t = 0; t < 16; ++t) rkraw2[t] = (unsigned)pr[(size_t)(16 + t) * NPROJ] | ((unsigned)pr[(size_t)(16 + t) * NPROJ + 512] << 16);
#pragma unroll
            for (int tb = 0; tb < 32; tb += 8) {
#pragma unroll
                for (int i = 0; i < 8; ++i) {
                    const int tok = tb + i, m = m0 + tok;
                    if (m >= MP && ((m - MP) & 3) == 0) { const float* sp = shs + (size_t)((m - MP) >> 2) * RWC + h * 64 + lane; rprev = sp[0]; kprev = sp[512]; }
                    const unsigned rkw = tok < 16 ? rkraw[tok & 15] : rkraw2[tok & 15];
                    const float rc = bf2f(rkw & 0xffffu), kc = bf2f(rkw >> 16);
                    const float r = rc + (rprev - rc) * mu_r, k = kc + (kprev - kc) * mu_k;
                    rprev = rc; kprev = kc;
                    const float kkr = k * c_kk; const float av = ALDS[tok * 64 + lane];
                    const float k2 = k * (1.f + (av - 1.f) * c_ka);
                    const float ssq = wave_sum_l63(kkr * kkr), rk = wave_sum_l63(r * k2 * c_rk);
                    if (lane == 63) { INV[(size_t)m * 8 + h] = 1.f / fmaxf(sqrtf(ssq), 1e-12f); RKR[(size_t)m * 8 + h] = rk; }
                }
            }
        }
    }
}

__device__ __forceinline__ int pop_job(unsigned* ctr, LAS int* slot, int tid) {
    __syncthreads();
    if (tid == 0) *slot = (int)atomicAdd(ctr, 1u);
    __syncthreads();
    return *slot;
}

__device__ __forceinline__ void rw_job(const Ctx& F0, int l, bool samp, int b, int h, int q) {
    const Ctx F = fresh(F0);
    CArgs a = get_args(); const int tid = F.tid, lane = F.lane, wave = F.wave, fr = lane & 15, fq = lane >> 4;
    const bf16_t* PROJ = (const bf16_t*)(a->ws + WS_PROJ);
    const bf16_t* WEXP = (const bf16_t*)(a->ws + WS_WEXP); const bf16_t* AVp = (const bf16_t*)(a->ws + WS_AV);
    const float* INV = (const float*)(a->ws + WS_INV); const float* RKR = (const float*)(a->ws + WS_RKR);
    bf16_t* BR = (bf16_t*)(a->ws + WS_BR); bf16_t* BOp = (bf16_t*)(a->ws + WS_BON);
    const int slen = samp ? SSEQ : SEQ; const size_t row0 = samp ? (size_t)MP + (size_t)b * SSEQ : (size_t)b * SEQ;
    const int nchunk = samp ? 1 : SEQ / 32, nvalid = samp ? SSEQ : 32;
    LAS float* OPS = (LAS float*)F.lds;
    LAS float* RK = OPS + 2 * 32 * 384;
    const bool scanw = wave < 4;
    const int cg = tid & 15;
    f32x4 mur, muk, muv, ckk, cka;
    {
        const float* mu = a->in[20] + l * RWC + h * 64 + cg * 4; const int chx = l * 512 + h * 64 + cg * 4;
        mur = *(const f32x4*)mu; muk = *(const f32x4*)(mu + 512); muv = *(const f32x4*)(mu + 1024);
        ckk = *(const f32x4*)(a->in[26] + chx); cka = *(const f32x4*)(a->in[27] + chx);
    }
    f32x4 S0 = (f32x4){0.f, 0.f, 0.f, 0.f}, S1 = S0;
    const int kq = lane & 7, rowi = lane >> 3;
    __syncthreads();
    for (int c = -1; c < nchunk; ++c) {
        if (!scanw) {
            const int cn = c + 1;
            if (cn < nchunk) {
                LAS float* ob = OPS + (cn & 1) * (32 * 384); LAS float* rkb = RK + (cn & 1) * 32;
#pragma unroll
                for (int i = 0; i < 2; ++i) {
                    const int it = (tid - 256) + 256 * i, tok = it >> 4;
                    if (tok < nvalid) {
                        const int tseq = cn * 32 + tok; const size_t m = row0 + tseq;
                        const bf16_t* pr = PROJ + m * NPROJ + C_CB + h * 64 + cg * 4;
                        const f32x4 rc = pg8::ld4(pr), kc = pg8::ld4(pr + 512), vc = pg8::ld4(pr + 1024);
                        f32x4 rp, kp, vp;
                        if (tseq > 0) { rp = pg8::ld4(pr - NPROJ); kp = pg8::ld4(pr - NPROJ + 512); vp = pg8::ld4(pr - NPROJ + 1024); }
                        else if (samp) { const float* sp = a->in[8] + ((size_t)l * NSB + b) * RWC + h * 64 + cg * 4; rp = *(const f32x4*)sp; kp = *(const f32x4*)(sp + 512); vp = *(const f32x4*)(sp + 1024); }
                        else { rp = (f32x4){0.f, 0.f, 0.f, 0.f}; kp = rp; vp = rp; }
                        const f32x4 r = rc + (rp - rc) * mur, k = kc + (kp - kc) * muk, v = vc + (vp - vc) * muv;
                        const f32x4 we = pg8::ld4(WEXP + m * 512 + h * 64 + cg * 4), av = pg8::ld4(AVp + m * 512 + h * 64 + cg * 4);
                        const float inv = INV[m * 8 + h];
                        f32x4 dec;
#pragma unroll
                        for (int j = 0; j < 4; ++j) dec[j] = __expf(we[j]);
                        const f32x4 kk = k * ckk * inv, k2 = k * ((av - 1.f) * cka + 1.f), kka = kk * av;
                        LAS float* o = ob + tok * 384 + cg * 4;
                        *(LAS f32x4*)(o) = dec; *(LAS f32x4*)(o + 64) = kk; *(LAS f32x4*)(o + 128) = kka; *(LAS f32x4*)(o + 192) = k2; *(LAS f32x4*)(o + 256) = r; *(LAS f32x4*)(o + 320) = v;
                        if (cg == 0) rkb[tok] = RKR[m * 8 + h];
                    }
                }
            }
        } else if (c >= 0) {
            const LAS float* ob = OPS + (c & 1) * (32 * 384); const LAS float* rkb = RK + (c & 1) * 32;
            const int nq = samp ? 2 : 1;
            for (int qq = 0; qq < nq; ++qq) {
                const int rowh = (samp ? qq : q) * 32 + wave * 8 + rowi;
                if (samp) { const float* sp = a->in[7] + ((((size_t)l * NSB + b) * 8 + h) * 64 + rowh) * 64 + kq * 8; S0 = *(const f32x4*)sp; S1 = *(const f32x4*)(sp + 4); }
                const LAS float* p = ob + kq * 8;
                float o0 = 0.f, o1 = 0.f, o2 = 0.f, o3 = 0.f, oc = 0.f;
#define RW_LOAD(X, tt_) do { const LAS float* p_ = p + (tt_) * 384; \
                    X##w0 = *(const LAS f32x4*)(p_); X##w1 = *(const LAS f32x4*)(p_ + 4); X##kk0 = *(const LAS f32x4*)(p_ + 64); X##kk1 = *(const LAS f32x4*)(p_ + 68); \
                    X##ka0 = *(const LAS f32x4*)(p_ + 128); X##ka1 = *(const LAS f32x4*)(p_ + 132); X##k0 = *(const LAS f32x4*)(p_ + 192); X##k1 = *(const LAS f32x4*)(p_ + 196); \
                    X##r0 = *(const LAS f32x4*)(p_ + 256); X##r1 = *(const LAS f32x4*)(p_ + 260); X##v = ob[(tt_) * 384 + 320 + rowh]; } while (0)
#define RW_STEP(X, tt_) do { \
                    const f32x4 pa_ = S0 * X##kk0 + S1 * X##kk1; float sk_ = (pa_[0] + pa_[1]) + (pa_[2] + pa_[3]); \
                    sk_ = DPP_ADD(sk_, 0xB1); sk_ = DPP_ADD(sk_, 0x4E); sk_ = DPP_ADD(sk_, 0x141); \
                    S0 = S0 * X##w0 + (X##k0 * X##v - X##ka0 * sk_); S1 = S1 * X##w1 + (X##k1 * X##v - X##ka1 * sk_); \
                    const f32x4 pb_ = S0 * X##r0 + S1 * X##r1; float o_ = (pb_[0] + pb_[1]) + (pb_[2] + pb_[3]); \
                    o_ = DPP_ADD(o_, 0xB1); o_ = DPP_ADD(o_, 0x4E); o_ = DPP_ADD(o_, 0x141); \
                    oc = (((tt_) & 7) == kq) ? o_ : oc; } while (0)
                f32x4 Aw0, Aw1, Akk0, Akk1, Aka0, Aka1, Ak0, Ak1, Ar0, Ar1, Bw0, Bw1, Bkk0, Bkk1, Bka0, Bka1, Bk0, Bk1, Br0, Br1; float Av, Bv;
                __builtin_amdgcn_s_setprio(3);
                RW_LOAD(A, 0);
                for (int t = 0; t < nvalid; t += 2) {
                    RW_LOAD(B, t + 1);
                    __builtin_amdgcn_sched_barrier(0);
                    RW_STEP(A, t);
                    { const int t2 = (t + 2 < 32) ? t + 2 : 31; RW_LOAD(A, t2); }
                    RW_STEP(B, t + 1);
                    __builtin_amdgcn_sched_barrier(0);
                    if (((t + 1) & 7) == 7 || t + 2 >= nvalid) { const int sl_ = (t + 1) >> 3; if (sl_ == 0) o0 = oc; else if (sl_ == 1) o1 = oc; else if (sl_ == 2) o2 = oc; else o3 = oc; }
                }
                __builtin_amdgcn_s_setprio(0);
#undef RW_LOAD
#undef RW_STEP
#pragma unroll
                for (int sl = 0; sl < 4; ++sl) {
                    const int t = sl * 8 + kq;
                    if (t < nvalid) {
                        const size_t m = row0 + (size_t)c * 32 + t;
                        BR[m * NBR + 1024 + h * 64 + rowh] = (bf16_t)f2bf(sl == 0 ? o0 : sl == 1 ? o1 : sl == 2 ? o2 : o3);
                        BOp[m * 512 + h * 64 + rowh] = (bf16_t)f2bf(rkb[t] * ob[t * 384 + 320 + rowh]);
                    }
                }
                if (samp) { float* sp = a->out + O_RWS + ((((size_t)l * NSB + b) * 8 + h) * 64 + rowh) * 64 + kq * 8; *(f32x4*)sp = S0; *(f32x4*)(sp + 4) = S1; }
            }
        }
        __syncthreads();
    }
    if (!samp && scanw) { const int rowh = q * 32 + wave * 8 + rowi; float* sp = a->out + O_RWP + ((((size_t)l * NB + b) * 8 + h) * 64 + rowh) * 64 + kq * 8; *(f32x4*)sp = S0; *(f32x4*)(sp + 4) = S1; }
    if (h == 0 && q == 0) {
        float* sh = a->out + (samp ? O_SHS + ((size_t)l * NSB + b) * RWC : O_SHP + ((size_t)l * NB + b) * RWC);
        for (int cidx = tid; cidx < RWC; cidx += 512) sh[cidx] = bf2f(PROJ[(row0 + slen - 1) * NPROJ + C_CB + cidx]);
    }
}

__device__ __forceinline__ void hg_pre(const Ctx& F0, int l) {
    const Ctx F = fresh(F0);
    CArgs a = get_args(); const int tid = F.tid, lane = F.lane, wave = F.wave, fr = lane & 15, fq = lane >> 4;
    const bf16_t* PROJ = (const bf16_t*)(a->ws + WS_PROJ);
    bf16_t* QSg = (bf16_t*)(a->ws + WS_HQS); float* O1g = (float*)(a->ws + WS_HO1); bf16_t* KVg = (bf16_t*)(a->ws + WS_HKV); float* EBg = (float*)(a->ws + WS_HEB); bf16_t* HGG = (bf16_t*)(a->ws + WS_HGG);
    LAS unsigned char* L = F.lds;
    constexpr int SQ = 136, SK = 72;
    LAS bf16_t* QT = (LAS bf16_t*)L; LAS bf16_t* QS = QT + 64 * SQ; LAS bf16_t* KT = QS + 64 * SQ;
    LAS bf16_t* KET = KT + 64 * SQ; LAS bf16_t* VT = KET + 128 * SK; LAS bf16_t* AM = VT + 128 * SK;
    LAS float* SEG = (LAS float*)(AM + 64 * SK);
    const int k = tid & 127, seg = tid >> 7;
    const int tt = wave & 3, vh = wave >> 2;
    for (int u = F.bid; u < 1024; u += F.G) {
        const int b = u >> 7, h = (u >> 5) & 3, c = u & 31;
        float lb = 0.f;
        if (l == 1) { const float l0 = a->in[18][h * 128 + k], l1 = a->in[18][512 + h * 128 + k]; const float mx = fmaxf(l0, l1); const float e0 = __expf(l0 - mx), e1 = __expf(l1 - mx); const float s0 = e0 / (e0 + e1), s1 = e1 / (e0 + e1); lb = (s0 + s1) - s0; }
        const float ngv = a->in[19][l * 512 + h * 128 + k];
        const size_t r0 = (size_t)b * SEQ + (size_t)c * 64;
        __syncthreads();
        float qs[16], kv[16], bc[16]; float run = 0.f;
        unsigned short rq[16], rf[16], rv[16], rg[16];
#pragma unroll
        for (int i = 0; i < 16; ++i) { const bf16_t* pp = PROJ + (r0 + seg * 16 + i) * NPROJ + h * 128 + k; rq[i] = pp[C_BQ]; rf[i] = pp[C_BF]; rv[i] = pp[C_BI]; rg[i] = pp[C_BG]; }
#pragma unroll
        for (int i = 0; i < 16; ++i) {
            const size_t r = r0 + seg * 16 + i;
            const float q = bf2f(rq[i]), fp = bf2f(rf[i]), gt = bf2f(rg[i]);
            VT[k * SK + seg * 16 + i] = rv[i];
            HGG[r * 512 + h * 128 + k] = (bf16_t)f2bf(ngv * siluf_(gt));
            const float ex = __expf(-fabsf(fp)); const float rcp = __builtin_amdgcn_rcpf(1.f + ex);
            const float sg = fp >= 0.f ? rcp : ex * rcp, sgn = fp >= 0.f ? ex * rcp : rcp;
            const float f = lb + (1.f - lb) * sg;
            kv[i] = (1.f - lb) * sgn;
            qs[i] = siluf_(q);
            run += __logf(fmaxf(f, 1e-20f)); bc[i] = run;
        }
        SEG[seg * 128 + k] = run;
        __syncthreads();
        {
            const float s0 = SEG[k], s1 = SEG[128 + k], s2 = SEG[256 + k], s3 = SEG[384 + k];
            const float off = seg == 0 ? 0.f : seg == 1 ? s0 : seg == 2 ? s0 + s1 : s0 + s1 + s2;
            const float ref = s0 + s1, btot = (s0 + s1) + (s2 + s3);
            if (seg == 0) EBg[(size_t)u * 128 + k] = __expf(btot);
#pragma unroll
            for (int i = 0; i < 16; ++i) {
                const float bb = off + bc[i]; const int t = seg * 16 + i;
                QS[t * SQ + k] = (bf16_t)f2bf(qs[i] * __expf(bb));
                QT[t * SQ + k] = (bf16_t)f2bf(qs[i] * __expf(bb - ref));
                KT[t * SQ + k] = (bf16_t)f2bf(kv[i] * __expf(ref - bb));
                KET[k * SK + t] = (bf16_t)f2bf(kv[i] * __expf(btot - bb));
            }
        }
        __syncthreads();
        { const int t = tid >> 3, c0 = (tid & 7) * 16; const LAS u32x4* sp = (const LAS u32x4*)(QS + t * SQ + c0); u32x4* dp = (u32x4*)(QSg + ((size_t)u * 64 + t) * 128 + c0); dp[0] = sp[0]; dp[1] = sp[1]; }
#pragma unroll
        for (int si = 0; si < 2; ++si) {
            const int st = vh * 2 + si;
            f32x4 acc = (f32x4){0.f, 0.f, 0.f, 0.f};
            if (st <= tt) {
#pragma unroll
                for (int ks = 0; ks < 4; ++ks)
                    acc = __builtin_amdgcn_mfma_f32_16x16x32_bf16(*(const LAS bf16x8*)(QT + (tt * 16 + fr) * SQ + ks * 32 + fq * 8), *(const LAS bf16x8*)(KT + (st * 16 + fr) * SQ + ks * 32 + fq * 8), acc, 0, 0, 0);
            }
#pragma unroll
            for (int j = 0; j < 4; ++j) { const int t = tt * 16 + fq * 4 + j, s = st * 16 + fr; AM[t * SK + s] = (bf16_t)f2bf((st <= tt && t >= s) ? acc[j] : 0.f); }
        }
#pragma unroll
        for (int vt = 0; vt < 8; ++vt) {
            f32x4 acc = (f32x4){0.f, 0.f, 0.f, 0.f};
#pragma unroll
            for (int ks = 0; ks < 2; ++ks)
                acc = __builtin_amdgcn_mfma_f32_16x16x32_bf16(*(const LAS bf16x8*)(KET + (wave * 16 + fr) * SK + ks * 32 + fq * 8), *(const LAS bf16x8*)(VT + (vt * 16 + fr) * SK + ks * 32 + fq * 8), acc, 0, 0, 0);
            u32x2 w; w.x = pk2(acc[0], acc[1]); w.y = pk2(acc[2], acc[3]);
            *(u32x2*)(KVg + (((size_t)u * 64 + wave * 8 + vt) * 64 + lane) * 4) = w;
        }
        __syncthreads();
#pragma unroll
        for (int vi = 0; vi < 4; ++vi) {
            const int vt = vh * 4 + vi; f32x4 acc = (f32x4){0.f, 0.f, 0.f, 0.f};
#pragma unroll
            for (int ks = 0; ks < 2; ++ks)
                acc = __builtin_amdgcn_mfma_f32_16x16x32_bf16(*(const LAS bf16x8*)(AM + (tt * 16 + fr) * SK + ks * 32 + fq * 8), *(const LAS bf16x8*)(VT + (vt * 16 + fr) * SK + ks * 32 + fq * 8), acc, 0, 0, 0);
            *(f32x4*)(O1g + (((size_t)u * 32 + tt * 8 + vt) * 64 + lane) * 4) = acc;
        }
    }
}

__device__ __forceinline__ void hg_seq_job(const Ctx& F0, int l, int b, int h, int vs) {
    const Ctx F = fresh(F0);
    CArgs a = get_args(); const int tid = F.tid, lane = F.lane, wave = F.wave, fr = lane & 15, fq = lane >> 4;
    const bf16_t* QSg = (const bf16_t*)(a->ws + WS_HQS); const float* O1g = (const float*)(a->ws + WS_HO1); const bf16_t* KVg = (const bf16_t*)(a->ws + WS_HKV); const float* EBg = (const float*)(a->ws + WS_HEB);
    bf16_t* BR = (bf16_t*)(a->ws + WS_BR);
    constexpr int SQ = 136;
    LAS bf16_t* ST = (LAS bf16_t*)F.lds;
    const int tt = wave & 3, vtl = wave >> 2, kt = wave;
    __syncthreads();
    for (int i = tid; i < 32 * SQ; i += 512) ST[i] = 0;
    f32x4 Sacc[2] = {(f32x4){0.f, 0.f, 0.f, 0.f}, (f32x4){0.f, 0.f, 0.f, 0.f}};
    const int u0 = (b * 4 + h) * 32;
    bf16x8 qf[4]; f32x4 o1; u32x2 kvr[2]; f32x4 eb;
#define HG_PREFETCH(cc) do { const size_t u = (size_t)(u0 + (cc)); \
        _Pragma("unroll") for (int ks = 0; ks < 4; ++ks) qf[ks] = *(const bf16x8*)(QSg + (u * 64 + tt * 16 + fr) * 128 + ks * 32 + fq * 8); \
        o1 = *(const f32x4*)(O1g + ((u * 32 + tt * 8 + vs * 2 + vtl) * 64 + lane) * 4); \
        _Pragma("unroll") for (int i = 0; i < 2; ++i) kvr[i] = *(const u32x2*)(KVg + ((u * 64 + kt * 8 + vs * 2 + i) * 64 + lane) * 4); \
        eb = *(const f32x4*)(EBg + u * 128 + kt * 16 + fq * 4); } while (0)
    HG_PREFETCH(0);
    __syncthreads();
    for (int c = 0; c < 32; ++c) {
        const bf16x8 q0 = qf[0], q1 = qf[1], q2 = qf[2], q3 = qf[3]; f32x4 acc = o1; const u32x2 kv0 = kvr[0], kv1 = kvr[1]; const f32x4 ebc = eb;
        if (c + 1 < 32) HG_PREFETCH(c + 1);
        const LAS bf16_t* Sb = ST + (c & 1) * (32 * SQ) + (vtl * 16 + fr) * SQ + fq * 8;
        acc = __builtin_amdgcn_mfma_f32_16x16x32_bf16(q0, *(const LAS bf16x8*)(Sb), acc, 0, 0, 0);
        acc = __builtin_amdgcn_mfma_f32_16x16x32_bf16(q1, *(const LAS bf16x8*)(Sb + 32), acc, 0, 0, 0);
        acc = __builtin_amdgcn_mfma_f32_16x16x32_bf16(q2, *(const LAS bf16x8*)(Sb + 64), acc, 0, 0, 0);
        acc = __builtin_amdgcn_mfma_f32_16x16x32_bf16(q3, *(const LAS bf16x8*)(Sb + 96), acc, 0, 0, 0);
        const size_t r0 = (size_t)b * SEQ + (size_t)c * 64;
#pragma unroll
        for (int j = 0; j < 4; ++j) BR[(r0 + tt * 16 + fq * 4 + j) * NBR + 512 + h * 128 + vs * 32 + vtl * 16 + fr] = (bf16_t)f2bf(acc[j]);
        LAS bf16_t* Sn = ST + ((c + 1) & 1) * (32 * SQ);
#pragma unroll
        for (int i = 0; i < 2; ++i) {
            const u32x2 kw = i == 0 ? kv0 : kv1;
            const f32x4 kvv = (f32x4){bf2f(kw.x & 0xffffu), bf2f(kw.x >> 16), bf2f(kw.y & 0xffffu), bf2f(kw.y >> 16)};
            Sacc[i] = Sacc[i] * ebc + kvv;
            u32x2 w; w.x = pk2(Sacc[i][0], Sacc[i][1]); w.y = pk2(Sacc[i][2], Sacc[i][3]);
            *(LAS u32x2*)(Sn + (i * 16 + fr) * SQ + kt * 16 + fq * 4) = w;
        }
        __syncthreads();
    }
#undef HG_PREFETCH
    float* so = a->out + O_HGP + (((size_t)l * NB + b) * 4 + h) * 128 * 128;
#pragma unroll
    for (int i = 0; i < 2; ++i)
#pragma unroll
        for (int j = 0; j < 4; ++j) so[(size_t)(kt * 16 + fq * 4 + j) * 128 + vs * 32 + i * 16 + fr] = Sacc[i][j];
}

__device__ __forceinline__ void hg_finish(const Ctx& F0) {
    const Ctx F = fresh(F0);
    CArgs a = get_args();
    const bf16_t* HGG = (const bf16_t*)(a->ws + WS_HGG); bf16_t* BR = (bf16_t*)(a->ws + WS_BR);
    const int gw = F.bid * 8 + F.wave, NGW = F.G * 8, lane = F.lane;
    for (int it0 = gw * 4; it0 < MP * 4; it0 += NGW * 4) {
        unsigned ov[4], gq[4]; unsigned* op[4];
#pragma unroll
        for (int q = 0; q < 4; ++q) { const int it = it0 + q, m = it >> 2, h = it & 3; op[q] = (unsigned*)(BR + (size_t)m * NBR + 512 + h * 128) + lane; ov[q] = *op[q]; gq[q] = *((const unsigned*)(HGG + (size_t)m * 512 + h * 128) + lane); }
#pragma unroll
        for (int q = 0; q < 4; ++q) { const float oa = bf2f(ov[q] & 0xffffu), ob = bf2f(ov[q] >> 16);
            const float rs = rsqrtf(wave_sum_all(oa * oa + ob * ob) * (1.f / 128.f) + EPS);
            *op[q] = pk2(oa * rs * bf2f(gq[q] & 0xffffu), ob * rs * bf2f(gq[q] >> 16)); }
    }
}

__device__ __forceinline__ void hg_sample_job(const Ctx& F0, int l, int b, int h) {
    const Ctx F = fresh(F0);
    CArgs a = get_args(); const int tid = F.tid, lane = F.lane, wave = F.wave;
    const bf16_t* PROJ = (const bf16_t*)(a->ws + WS_PROJ); bf16_t* BR = (bf16_t*)(a->ws + WS_BR);
    LAS float* FF = (LAS float*)F.lds;
    LAS float* KV = FF + 512; LAS float* QSs = KV + 512; LAS float* VV = QSs + 512;
    LAS float* RED = VV + 512;
    LAS float* SSQ = RED + 8192;
    const size_t row0 = (size_t)MP + (size_t)b * SSEQ;
    __syncthreads();
    {
        const int t = tid >> 7, k = tid & 127;
        float lb = 0.f;
        if (l == 1) { const float l0 = a->in[18][h * 128 + k], l1 = a->in[18][512 + h * 128 + k]; const float mx = fmaxf(l0, l1); const float e0 = __expf(l0 - mx), e1 = __expf(l1 - mx); const float s0 = e0 / (e0 + e1), s1 = e1 / (e0 + e1); lb = (s0 + s1) - s0; }
        const size_t r = row0 + t;
        const float q = bf2f(PROJ[r * NPROJ + C_BQ + h * 128 + k]), fp = bf2f(PROJ[r * NPROJ + C_BF + h * 128 + k]);
        const float ex = __expf(-fp), sg = 1.f / (1.f + ex);
        const float f = lb + (1.f - lb) * sg;
        FF[tid] = __expf(__logf(fmaxf(f, 1e-20f)));
        KV[tid] = (1.f - lb) * (fp > 0.f ? ex * sg : 1.f / (1.f + __expf(fp)));
        QSs[tid] = siluf_(q);
        VV[tid] = bf2f(PROJ[r * NPROJ + C_BI + h * 128 + k]);
    }
    const int v4 = tid & 31, kg = tid >> 5;
    const float* s0 = a->in[6] + (((size_t)l * NSB + b) * 4 + h) * 128 * 128;
    f32x4 S[8];
#pragma unroll
    for (int i = 0; i < 8; ++i) S[i] = *(const f32x4*)(s0 + (size_t)(kg * 8 + i) * 128 + v4 * 4);
    __syncthreads();
#pragma unroll
    for (int t = 0; t < 4; ++t) {
        const f32x4 vv = *(const LAS f32x4*)(VV + t * 128 + v4 * 4); f32x4 po = (f32x4){0.f, 0.f, 0.f, 0.f};
#pragma unroll
        for (int i = 0; i < 8; ++i) { const int kx = t * 128 + kg * 8 + i; S[i] = S[i] * FF[kx] + vv * KV[kx]; po = po + S[i] * QSs[kx]; }
        *(LAS f32x4*)(RED + (t * 16 + kg) * 128 + v4 * 4) = po;
    }
    float* so = a->out + O_HGS + (((size_t)l * NSB + b) * 4 + h) * 128 * 128;
#pragma unroll
    for (int i = 0; i < 8; ++i) *(f32x4*)(so + (size_t)(kg * 8 + i) * 128 + v4 * 4) = S[i];
    __syncthreads();
    {
        const int t = tid >> 7, v = tid & 127; float o = 0.f;
#pragma unroll
        for (int g = 0; g < 16; ++g) o += RED[(t * 16 + g) * 128 + v];
        const float p = wave_sum(o * o);
        if (lane == 0) SSQ[wave] = p;
        __syncthreads();
        const float rs = rsqrtf((SSQ[t * 2] + SSQ[t * 2 + 1]) * (1.f / 128.f) + EPS);
        const size_t r = row0 + t;
        const float gt = bf2f(PROJ[r * NPROJ + C_BG + h * 128 + v]);
        BR[r * NBR + 512 + h * 128 + v] = (bf16_t)f2bf(o * rs * a->in[19][l * 512 + h * 128 + v] * siluf_(gt));
    }
}

__device__ __forceinline__ void lru_job(const Ctx& F0, int l, bool samp, int bidx, int blk) {
    const Ctx F = fresh(F0);
    CArgs a = get_args(); const int tid = F.tid, lane = F.lane, wave = F.wave, fr = lane & 15, fq = lane >> 4;
    const bf16_t* PROJ = (const bf16_t*)(a->ws + WS_PROJ); bf16_t* BR = (bf16_t*)(a->ws + WS_BR);
    LAS float* XC = (LAS float*)F.lds;
    LAS float* AS = XC + 4096; LAS float* BS = AS + 4096;
    LAS float* SEGA = BS + 4096; LAS float* SEGB = SEGA + 512;
    LAS float* CARRY = SEGB + 512;
    LAS bf16_t* XCB = (LAS bf16_t*)(CARRY + 64);
    const size_t row0 = samp ? (size_t)MP + (size_t)bidx * 64 : (size_t)bidx * SEQ;
    const int nchunk = samp ? 1 : SEQ / 64;
    const int cc = tid & 63, tq = tid >> 6, ch = blk * 64 + cc;
    const float cw0 = a->in[11][(l * 4 + 0) * 512 + ch], cw1 = a->in[11][(l * 4 + 1) * 512 + ch], cw2 = a->in[11][(l * 4 + 2) * 512 + ch], cw3 = a->in[11][(l * 4 + 3) * 512 + ch];
    const float cb = a->in[12][l * 512 + ch];
    bf16x8 Ba[2][2], Bx[2][2];
#pragma unroll
    for (int ji = 0; ji < 2; ++ji) { const int j = ((wave >> 2) * 2 + ji) * 16 + fr;
        const bf16_t* wa = (const bf16_t*)(a->ws + WS_W + W_LWA) + blk * 4096 + j * 64; const bf16_t* wx = (const bf16_t*)(a->ws + WS_W + W_LWX) + blk * 4096 + j * 64;
#pragma unroll
        for (int ks = 0; ks < 2; ++ks) { Ba[ji][ks] = *(const bf16x8*)(wa + ks * 32 + fq * 8); Bx[ji][ks] = *(const bf16x8*)(wx + ks * 32 + fq * 8); } }
    __syncthreads();
    if (tid < 64) CARRY[tid] = 0.f;
    for (int c = 0; c < nchunk; ++c) {
        {
            float x[11];
#pragma unroll
            for (int i = 0; i < 11; ++i) {
                const long p = (long)c * 64 + tq * 8 + i - 3;
                x[i] = (!samp && p >= 0) ? bf2f(PROJ[(row0 + p) * NPROJ + C_XA + ch]) : 0.f;
            }
#pragma unroll
            for (int i = 0; i < 8; ++i) {
                const int t = tq * 8 + i; float x0 = x[i], x1 = x[i + 1], x2 = x[i + 2], x3 = x[i + 3];
                if (samp) {
                    const int tl = t & 3, bb = bidx * 16 + (t >> 2);
                    const float* cs = a->in[4] + ((size_t)l * NSB + bb) * 3 * 512 + ch;
                    const bf16_t* pr = PROJ + (row0 + t) * NPROJ + C_XA + ch;
                    x3 = bf2f(pr[0]);
                    x2 = (tl >= 1) ? bf2f(*(pr - (size_t)NPROJ)) : cs[(size_t)(2 + tl) * 512];
                    x1 = (tl >= 2) ? bf2f(*(pr - (size_t)2 * NPROJ)) : cs[(size_t)(1 + tl) * 512];
                    x0 = (tl >= 3) ? bf2f(*(pr - (size_t)3 * NPROJ)) : cs[(size_t)(tl) * 512];
                }
                const float xc = cb + x0 * cw0 + x1 * cw1 + x2 * cw2 + x3 * cw3;
                XC[t * 64 + cc] = xc; XCB[t * 72 + cc] = (bf16_t)f2bf(xc);
            }
        }
        __syncthreads();
        {
            const int tt = wave & 3;
#pragma unroll
            for (int ji = 0; ji < 2; ++ji) {
                f32x4 ar = (f32x4){0.f, 0.f, 0.f, 0.f}, ax = ar;
#pragma unroll
                for (int ks = 0; ks < 2; ++ks) { const bf16x8 av = *(const LAS bf16x8*)(XCB + (tt * 16 + fr) * 72 + ks * 32 + fq * 8);
                    ar = __builtin_amdgcn_mfma_f32_16x16x32_bf16(av, Ba[ji][ks], ar, 0, 0, 0); ax = __builtin_amdgcn_mfma_f32_16x16x32_bf16(av, Bx[ji][ks], ax, 0, 0, 0); }
                const int j = ((wave >> 2) * 2 + ji) * 16 + fr, chj = blk * 64 + j;
                const float ba = a->in[14][l * 512 + chj], bx = a->in[16][l * 512 + chj], sp = softplusf_(-a->in[17][l * 512 + chj]);
#pragma unroll
                for (int jj = 0; jj < 4; ++jj) {
                    const int t = tt * 16 + fq * 4 + jj;
                    const float rg = sigmoidf_(ar[jj] + ba), ig = sigmoidf_(ax[jj] + bx);
                    const float la = -8.f * rg * sp; float av = __expf(la);
                    const bool first = samp ? ((t & 3) == 0) : (c == 0 && t == 0);
                    float mult = sqrtf(fmaxf(-expm1f(2.f * la), 0.f));
                    if (!samp && first) mult = 1.f;
                    float bv = XC[t * 64 + j] * ig * mult;
                    if (first) { const float h0 = samp ? a->in[5][((size_t)l * NSB + bidx * 16 + (t >> 2)) * 512 + chj] : 0.f; bv += av * h0; av = 0.f; }
                    AS[t * 64 + j] = av; BS[t * 64 + j] = bv;
                }
            }
        }
        __syncthreads();
        {
            float Ai[8], Bi[8]; float A = 1.f, B = 0.f;
#pragma unroll
            for (int i = 0; i < 8; ++i) { const int t = tq * 8 + i; const float av = AS[t * 64 + cc], bv = BS[t * 64 + cc]; B = av * B + bv; A = av * A; Ai[i] = A; Bi[i] = B; }
            SEGA[tq * 64 + cc] = A; SEGB[tq * 64 + cc] = B;
            __syncthreads();
            float hin = CARRY[cc];
            for (int s = 0; s < tq; ++s) hin = SEGA[s * 64 + cc] * hin + SEGB[s * 64 + cc];
            float hl = 0.f;
#pragma unroll
            for (int i = 0; i < 8; ++i) {
                const int t = tq * 8 + i; const size_t r = row0 + (size_t)c * 64 + t;
                const float hv = Ai[i] * hin + Bi[i]; hl = hv;
                const float gav = bf2f(PROJ[r * NPROJ + C_GA + ch]);
                BR[r * NBR + ch] = (bf16_t)f2bf(hv * gelu_tanh(gav));
                if (samp && (t & 3) == 3) a->out[O_LRUS + ((size_t)l * NSB + bidx * 16 + (t >> 2)) * 512 + ch] = hv;
            }
            __syncthreads();
            if (tq == 7) { CARRY[cc] = hl; if (!samp && c == nchunk - 1) a->out[O_LRUP + ((size_t)l * NB + bidx) * 512 + ch] = hl; }
        }
        __syncthreads();
    }
    if (!samp) { if (tid < 192) { const int j = tid >> 6; a->out[O_CONVP + (((size_t)l * NB + bidx) * 3 + j) * 512 + ch] = bf2f(PROJ[(row0 + SEQ - 3 + j) * NPROJ + C_XA + ch]); } }
    else { for (int e = tid; e < 16 * 3 * 64; e += 512) { const int c2 = e & 63, j = (e >> 6) % 3, bb = e / 192;
            a->out[O_CONVS + (((size_t)l * NSB + bidx * 16 + bb) * 3 + j) * 512 + blk * 64 + c2] = bf2f(PROJ[(row0 + bb * 4 + 1 + j) * NPROJ + C_XA + blk * 64 + c2]); } }
}

__device__ __forceinline__ void lru_pre(const Ctx& F0, int l) {
    const Ctx F = fresh(F0);
    CArgs a = get_args(); const int tid = F.tid, lane = F.lane, wave = F.wave, fr = lane & 15, fq = lane >> 4;
    const bf16_t* PROJ = (const bf16_t*)(a->ws + WS_PROJ); bf16_t* BR = (bf16_t*)(a->ws + WS_BR); bf16_t* LLA = (bf16_t*)(a->ws + WS_LLA);
    LAS float* XC = (LAS float*)F.lds;
    LAS bf16_t* XCB = (LAS bf16_t*)(XC + 4096);
    const int cc = tid & 63, tq = tid >> 6;
    for (int u = F.bid; u < 2048; u += F.G) {
        const int tile = u >> 3, blk = u & 7, c = tile & 31, ch = blk * 64 + cc; const size_t r0 = (size_t)tile * 64;
        const float cw0 = a->in[11][(l * 4 + 0) * 512 + ch], cw1 = a->in[11][(l * 4 + 1) * 512 + ch], cw2 = a->in[11][(l * 4 + 2) * 512 + ch], cw3 = a->in[11][(l * 4 + 3) * 512 + ch];
        const float cb = a->in[12][l * 512 + ch];
        __syncthreads();
        {
            float x[11];
#pragma unroll
            for (int i = 0; i < 11; ++i) { const int p = c * 64 + tq * 8 + i - 3; x[i] = p >= 0 ? bf2f(PROJ[(r0 + tq * 8 + i - 3) * NPROJ + C_XA + ch]) : 0.f; }
#pragma unroll
            for (int i = 0; i < 8; ++i) { const int t = tq * 8 + i; const float xc = cb + x[i] * cw0 + x[i + 1] * cw1 + x[i + 2] * cw2 + x[i + 3] * cw3; XC[t * 64 + cc] = xc; XCB[t * 72 + cc] = (bf16_t)f2bf(xc); }
        }
        __syncthreads();
        {
            const int tt = wave & 3;
#pragma unroll
            for (int ji = 0; ji < 2; ++ji) {
                const int j = ((wave >> 2) * 2 + ji) * 16 + fr, chj = blk * 64 + j;
                const bf16_t* wa = (const bf16_t*)(a->ws + WS_W + W_LWA) + blk * 4096 + j * 64; const bf16_t* wx = (const bf16_t*)(a->ws + WS_W + W_LWX) + blk * 4096 + j * 64;
                f32x4 ar = (f32x4){0.f, 0.f, 0.f, 0.f}, ax = ar;
#pragma unroll
                for (int ks = 0; ks < 2; ++ks) { const bf16x8 av = *(const LAS bf16x8*)(XCB + (tt * 16 + fr) * 72 + ks * 32 + fq * 8);
                    ar = __builtin_amdgcn_mfma_f32_16x16x32_bf16(av, *(const bf16x8*)(wa + ks * 32 + fq * 8), ar, 0, 0, 0); ax = __builtin_amdgcn_mfma_f32_16x16x32_bf16(av, *(const bf16x8*)(wx + ks * 32 + fq * 8), ax, 0, 0, 0); }
                const float ba = a->in[14][l * 512 + chj], bx = a->in[16][l * 512 + chj], sp = softplusf_(-a->in[17][l * 512 + chj]);
#pragma unroll
                for (int jj = 0; jj < 4; ++jj) {
                    const int t = tt * 16 + fq * 4 + jj;
                    const float rg = sigmoidf_(ar[jj] + ba), ig = sigmoidf_(ax[jj] + bx);
                    float la = -8.f * rg * sp;
                    const bool first = (c == 0 && t == 0);
                    const float mult = first ? 1.f : sqrtf(fmaxf(-expm1f(2.f * la), 0.f));
                    const float bv = XC[t * 64 + j] * ig * mult;
                    if (first) la = -__builtin_inff();
                    BR[(r0 + t) * NBR + chj] = (bf16_t)f2bf(bv); LLA[(r0 + t) * 512 + chj] = (bf16_t)f2bf(la);
                }
            }
        }
    }
}

__device__ __forceinline__ void lru_seq_job(const Ctx& F0, int l, int b, int blk) {
    const Ctx F = fresh(F0);
    CArgs a = get_args(); const int tid = F.tid;
    const bf16_t* PROJ = (const bf16_t*)(a->ws + WS_PROJ); bf16_t* BR = (bf16_t*)(a->ws + WS_BR); const bf16_t* LLA = (const bf16_t*)(a->ws + WS_LLA);
    LAS float* SEGA = (LAS float*)F.lds; LAS float* SEGB = SEGA + 512;
    const int cc = tid & 63, sg = tid >> 6, ch = blk * 64 + cc; const size_t row0 = (size_t)b * SEQ + (size_t)sg * 256;
    float A = 1.f, B = 0.f;
#pragma unroll 1
    for (int tb = 0; tb < 256; tb += 16) {
        unsigned short la[16], bb[16];
#pragma unroll
        for (int i = 0; i < 16; ++i) { la[i] = LLA[(row0 + tb + i) * 512 + ch]; bb[i] = BR[(row0 + tb + i) * NBR + ch]; }
#pragma unroll
        for (int i = 0; i < 16; ++i) { const float av = __expf(bf2f(la[i])), bv = bf2f(bb[i]); B = av * B + bv; A = av * A; }
    }
    __syncthreads();
    SEGA[sg * 64 + cc] = A; SEGB[sg * 64 + cc] = B;
    __syncthreads();
    float h = 0.f;
    for (int s = 0; s < sg; ++s) h = SEGA[s * 64 + cc] * h + SEGB[s * 64 + cc];
#pragma unroll 1
    for (int tb = 0; tb < 256; tb += 16) {
        unsigned short la[16], bb[16], ga[16];
#pragma unroll
        for (int i = 0; i < 16; ++i) { la[i] = LLA[(row0 + tb + i) * 512 + ch]; bb[i] = BR[(row0 + tb + i) * NBR + ch]; ga[i] = PROJ[(row0 + tb + i) * NPROJ + C_GA + ch]; }
#pragma unroll
        for (int i = 0; i < 16; ++i) {
            h = __expf(bf2f(la[i])) * h + bf2f(bb[i]);
            BR[(row0 + tb + i) * NBR + ch] = (bf16_t)f2bf(h * gelu_tanh(bf2f(ga[i])));
        }
    }
    if (sg == 7) a->out[O_LRUP + ((size_t)l * NB + b) * 512 + ch] = h;
    if (tid < 192) { const int j = tid >> 6; a->out[O_CONVP + (((size_t)l * NB + b) * 3 + j) * 512 + ch] = bf2f(PROJ[((size_t)b * SEQ + SEQ - 3 + j) * NPROJ + C_XA + ch]); }
}

__device__ __forceinline__ void scan_phase(const Ctx& F, int l) {
    unsigned* ctrA = (unsigned*)(get_args()->ws + WS_CTL) + 64 * l;
    unsigned* ctrB = (unsigned*)(get_args()->ws + WS_CTL) + 64 * l + 128;
    LAS int* slot = (LAS int*)(F.lds + LDS_BYTES - 16);
    const Ctx Fq = fresh(F);
    constexpr int J_HGP = 128, J_LRUP = 64, J_LRUS = 64, J_HGS = 512, J_RWS = 1024;
    const bool split = (F.G == 256);
    int stage = split ? (F.bid < 128 ? 0 : 1) : 3;
    for (;;) {
        int type = -1, p0 = 0, p1 = 0, p2 = 0; bool samp = false;
        if (stage == 0) { const int j = F.bid; type = 0; p0 = j >> 4; p1 = (j >> 1) & 7; p2 = j & 1; stage = 2; }
        else if (stage == 1 || stage == 3) {
            int j = pop_job(ctrA, slot, Fq.tid);
            if (stage == 3 && j < 128) { type = 0; p0 = j >> 4; p1 = (j >> 1) & 7; p2 = j & 1; }
            else {
                if (stage == 3) j -= 128;
                if (j < J_HGP) { type = 1; p0 = j >> 4; p1 = (j >> 2) & 3; p2 = j & 3; }
                else if ((j -= J_HGP) < J_LRUP) { type = 4; p0 = j >> 3; p1 = j & 7; }
                else {
                    unsigned char* wsb = get_args()->ws;
                    pg8::Gemm g{(const bf16_t*)(wsb + WS_XN), (const bf16_t*)(wsb + WS_W + W_IN + (size_t)NPROJ * D * 2), D, D, D};
                    pg8::Order S; if (stage == 1) S.init(M, NGATE, 128, F.bid - 128, 0); else S.init(M, NGATE, F.G, F.bid, 0);
                    pg8::Epi E{pg8::EP_SIGMOID, (bf16_t*)(wsb + WS_G2), NGATE, nullptr, 0};
                    pg8::gemm_phase(F.lds, F.wave, g, S, E);
                    stage = 2; continue;
                }
            }
        } else {
            int j = pop_job(ctrB, slot, Fq.tid);
            if (j >= J_LRUS + J_HGS + J_RWS) break;
            if (j < J_LRUS) { type = 2; samp = true; p0 = j >> 3; p1 = j & 7; }
            else if ((j -= J_LRUS) < J_HGS) { type = 3; p0 = j >> 2; p1 = j & 3; }
            else { j -= J_HGS; type = 0; samp = true; p0 = j >> 3; p1 = j & 7; p2 = 0; }
        }
        if (type == 0) rw_job(F, l, samp, p0, p1, p2);
        else if (type == 1) hg_seq_job(F, l, p0, p1, p2);
        else if (type == 2) lru_job(F, l, samp, p0, p1);
        else if (type == 4) lru_seq_job(F, l, p0, p1);
        else hg_sample_job(F, l, p0, p1);
    }
}

__device__ __forceinline__ void sample_gemm(const Ctx& F0, const bf16_t* A, int lda, const bf16_t* Bt, int K, int mode, bf16_t* O, const bf16_t* G, int three) {
    const Ctx F = fresh(F0); const int lane = F.lane, wave = F.wave, fr = lane & 15, fq = lane >> 4;
    for (int tile = F.bid; tile < 256; tile += F.G) {
        const int row0 = MP + (tile >> 4) * 32 + (wave & 1) * 16, col0 = (tile & 15) * 64 + (wave >> 1) * 16;
        f32x4 sacc = (f32x4){0.f, 0.f, 0.f, 0.f};
        const int nparts = three ? 3 : 1;
        for (int n = 0; n < nparts; ++n) {
            const bf16_t* Ap = A + (size_t)(row0 + fr) * lda + n * 512 + fq * 8;
            const bf16_t* Bp = Bt + (size_t)(n * 1024 + col0 + fr) * K + fq * 8;
            f32x4 acc = (f32x4){0.f, 0.f, 0.f, 0.f};
#pragma unroll 1
            for (int k0 = 0; k0 < K; k0 += 256) {
                bf16x8 av[8], bv[8];
#pragma unroll
                for (int i = 0; i < 8; ++i) { av[i] = *(const bf16x8*)(Ap + k0 + i * 32); bv[i] = *(const bf16x8*)(Bp + k0 + i * 32); }
#pragma unroll
                for (int i = 0; i < 8; ++i) acc = __builtin_amdgcn_mfma_f32_16x16x32_bf16(av[i], bv[i], acc, 0, 0, 0);
            }
            if (three) {
#pragma unroll
                for (int j = 0; j < 4; ++j) sacc[j] += acc[j] * bf2f(G[(size_t)(row0 + fq * 4 + j) * NGATE + n * 1024 + col0 + fr]);
            } else sacc = acc;
        }
#pragma unroll
        for (int j = 0; j < 4; ++j) {
            bf16_t* op = O + (size_t)(row0 + fq * 4 + j) * D + col0 + fr; float v = sacc[j];
            if (mode == pg8::EP_SIGMOID) v = sigmoidf_(v);
            if (mode == pg8::EP_MULINPLACE) v *= bf2f(*op);
            *op = (bf16_t)f2bf(v);
        }
    }
}

#define XB_TMO      128
#define XB_XCNT(j)  (256  + 64 * (j))
#define XB_XSUB(j)  (1280 + 64 * (j))
#define XB_XGEN(j)  (2304 + 64 * (j))
#define XB_TOP      3328
#define XB_TOPGEN   3392
#define XCD_BAR_WORDS 3456
#define XB_SPIN_CAP (1u << 22)
__device__ __forceinline__ unsigned xb_ld(unsigned* p)              { return __hip_atomic_load(p, __ATOMIC_RELAXED, __HIP_MEMORY_SCOPE_AGENT); }
__device__ __forceinline__ unsigned xb_add(unsigned* p, unsigned v) { return __hip_atomic_fetch_add(p, v, __ATOMIC_RELAXED, __HIP_MEMORY_SCOPE_AGENT); }
__device__ __forceinline__ unsigned xb_xcc_id() { return (unsigned)__builtin_amdgcn_s_getreg((3 << 11) | 20) & 0xFu; }
#define XB_SPIN(cond, bar) do { unsigned _sp = 0; while (cond) { __builtin_amdgcn_s_sleep(1); \
    if ((++_sp & 255u) == 0u) { if (xb_ld(&(bar)[XB_TMO])) break; if (_sp > XB_SPIN_CAP) { atomicAdd(&(bar)[XB_TMO], 1u); break; } } } } while (0)
__device__ __forceinline__ void xcd_barrier_complete(unsigned* bar, unsigned x, unsigned G, unsigned& nloc, unsigned& nx) {
    unsigned sum, cnt, mine, sp = 0u;
    for (;;) {
        sum = 0u; cnt = 0u; mine = 0u;
#pragma unroll
        for (unsigned j = 0; j < 16; ++j) { const unsigned c = xb_ld(&bar[XB_XCNT(j)]); sum += c; cnt += (c > 0u) ? 1u : 0u; mine = (j == x) ? c : mine; }
        if (sum == G) break;
        __builtin_amdgcn_s_sleep(1);
        if ((++sp & 255u) == 0u) { if (xb_ld(&bar[XB_TMO])) break; if (sp > XB_SPIN_CAP) { atomicAdd(&bar[XB_TMO], 1u); break; } }
    }
    nloc = mine > 0u ? mine : 1u; nx = cnt > 0u ? cnt : 1u;
}
__device__ __forceinline__ void xcd_barrier(const Ctx& F0) {
    const Ctx F = fresh(F0);
    asm volatile("s_waitcnt vmcnt(0)" ::: "memory");
    __syncthreads();
    if (F.tid == 0) {
        unsigned* bar = (unsigned*)(get_args()->ws + WS_CTL) + 1024;
        volatile LAS unsigned* st = (volatile LAS unsigned*)(F.lds + LDS_BYTES - 64);
        const unsigned x = xb_xcc_id();
        __builtin_amdgcn_s_waitcnt(0);
        unsigned nloc = st[0], nx = st[1];
        if (nloc == 0u) { xcd_barrier_complete(bar, x, (unsigned)F.G, nloc, nx); st[0] = nloc; st[1] = nx; }
        const unsigned old = xb_add(&bar[XB_XSUB(x)], 1u);
        const unsigned gen = old / nloc;
        if (old + 1u == (gen + 1u) * nloc) {
            __builtin_amdgcn_fence(__ATOMIC_RELEASE, "agent");
            asm volatile("s_waitcnt vmcnt(0)" ::: "memory");
            const unsigned og = xb_add(&bar[XB_TOP], 1u);
            const unsigned tg = og / nx;
            if (og + 1u == (tg + 1u) * nx) xb_add(&bar[XB_TOPGEN], 1u);
            else XB_SPIN(xb_ld(&bar[XB_TOPGEN]) == tg, bar);
            __builtin_amdgcn_fence(__ATOMIC_ACQUIRE, "agent");
            xb_add(&bar[XB_XGEN(x)], 1u);
            asm volatile("s_waitcnt vmcnt(0)" ::: "memory");
        } else {
            XB_SPIN(xb_ld(&bar[XB_XGEN(x)]) == gen, bar);
            __builtin_amdgcn_fence(__ATOMIC_ACQUIRE, "agent");
            asm volatile("s_waitcnt vmcnt(0)" ::: "memory");
        }
    }
    __syncthreads();
}

__global__ void __launch_bounds__(512) fwd_kernel(Args args) {
    extern __shared__ __attribute__((aligned(16))) unsigned char lds_raw[];
    cg::grid_group grid = cg::this_grid();
    Ctx F; F.lds = (LAS unsigned char*)lds_raw; F.wave = __builtin_amdgcn_readfirstlane((int)(threadIdx.x >> 6));
    F.lane = (int)__builtin_amdgcn_mbcnt_hi(~0u, __builtin_amdgcn_mbcnt_lo(~0u, 0u)); F.tid = F.wave * 64 + F.lane;
    F.G = gridDim.x; F.bid = blockIdx.x;
    if (F.tid < 16) ((LAS unsigned*)(F.lds + LDS_BYTES - 64))[F.tid] = 0u;
    if (F.tid == 0) (void)xb_add((unsigned*)(get_args()->ws + WS_CTL) + 1024 + XB_XCNT(xb_xcc_id()), 1u);
    __syncthreads();
#define WSP(off) ((bf16_t*)(get_args()->ws + (off)))

    grid.sync();
#pragma unroll 1
    for (int ph = 0; ph < 25; ++ph) {
        const bool pro = (ph == 0); const int l = pro ? 0 : (ph - 1) / 12, k = pro ? -1 : (ph - 1) % 12;
        if (pro || (k == 11 && l == 0)) convert_weights(F, pro ? 0 : 1);
        if (pro || k == 5 || k == 8 || k == 11) {
            const int mode = pro ? 0 : (k == 8 ? 2 : 1);
            const float* gp = get_args()->in[k == 5 ? 33 : k == 8 ? 38 : 41] + l * D;
            row_pass(F, mode, l, WSP(WS_PROJ + OV_MIX), gp, !(l == 1 && k == 11));
        } else if (k == 2) {
            rw_finish(F, l); hg_finish(F);
        } else if (k == 1) {
            rw_prepass(F, l);
            hg_pre(F, l);
            lru_pre(F, l);
            xcd_barrier(F);
            scan_phase(F, l);
        } else {
            size_t aoff = WS_XN, boff = W_IN, ooff = WS_PROJ, goff = WS_G2; int K = D, lda = D, ldb = D, N = NPROJ, mode = pg8::EP_STORE, ldc = NPROJ, three = 0;
            switch (k) {
                case 0: break;
                case 3: aoff = WS_BR; lda = NBR; boff = W_BR; ldb = 512; K = 512; N = D; three = 1; mode = pg8::EP_GATEACC; ooff = WS_PROJ + OV_S; ldc = D; break;
                case 4: aoff = WS_PROJ + OV_S; boff = W_OUT; N = D; ooff = WS_PROJ + OV_MIX; ldc = D; break;
                case 6: boff = W_GU; N = 2 * DFF; mode = pg8::EP_GLU; ooff = WS_PROJ + OV_HID; ldc = DFF; break;
                case 7: aoff = WS_PROJ + OV_HID; lda = DFF; boff = W_DN; ldb = DFF; K = DFF; N = D; ooff = WS_PROJ + OV_MIX; ldc = D; break;
                case 9: boff = W_PG; N = D; mode = pg8::EP_SIGMOID; ooff = WS_PROJ + OV_MIX; ldc = D; break;
                default: aoff = WS_PB; lda = PLE; boff = W_PLE; ldb = PLE; K = PLE; N = D; mode = pg8::EP_MULINPLACE; ooff = WS_PROJ + OV_MIX; ldc = D; break;
            }
            unsigned char* wsb = get_args()->ws;
            const bool n1024 = (N == D);
            if (n1024) sample_gemm(F, (const bf16_t*)(wsb + aoff), lda, (const bf16_t*)(wsb + WS_W + boff), K, mode, (bf16_t*)(wsb + ooff), (const bf16_t*)(wsb + goff), three);
            pg8::Gemm g{(const bf16_t*)(wsb + aoff), (const bf16_t*)(wsb + WS_W + boff), K, lda, ldb};
            pg8::Order S; S.init(n1024 ? MP : M, N, F.G, F.bid, three);
            pg8::Epi E{mode, (bf16_t*)(wsb + ooff), ldc, (const bf16_t*)(wsb + goff), NGATE};
            pg8::gemm_phase(F.lds, F.wave, g, S, E);
        }
        if (k != 9) xcd_barrier(F);
    }
}

extern "C" void kernel_launch(void* const* d_in, const int* in_sizes, int n_in, void* d_out, int out_size, void* d_ws, size_t ws_size, hipStream_t stream) {
    static int grid = 0;
    if (grid == 0) {
        if (n_in != 42 || out_size != (int)O_END || ws_size < WS_END) { fprintf(stderr, "kernel_launch: bad shapes: n_in %d out %d ws %zu (need %zu)\n", n_in, out_size, ws_size, (size_t)WS_END); grid = -1; return; }
        int dev = 0, cus = 0, per_cu = 0;
        (void)hipGetDevice(&dev); (void)hipDeviceGetAttribute(&cus, hipDeviceAttributeMultiprocessorCount, dev);
        (void)hipFuncSetAttribute((const void*)fwd_kernel, hipFuncAttributeMaxDynamicSharedMemorySize, LDS_BYTES);
        (void)hipOccupancyMaxActiveBlocksPerMultiprocessor(&per_cu, (const void*)fwd_kernel, 512, LDS_BYTES);
        if (per_cu < 1) per_cu = 1;
        grid = cus * per_cu; (void)hipGetLastError();
    }
    if (grid < 0) return;
    (void)hipMemsetAsync((char*)d_ws + WS_CTL, 0, 32768, stream);
    Args a{};
    for (int i = 0; i < 42; ++i) a.in[i] = (const float*)d_in[i];
    a.out = (float*)d_out; a.ws = (unsigned char*)d_ws;
    void* params[] = {&a};
    hipError_t e = hipLaunchCooperativeKernel((const void*)fwd_kernel, dim3(grid), dim3(512), params, LDS_BYTES, stream);
    if (e != hipSuccess) fprintf(stderr, "cooperative launch failed: %s (grid %d)\n", hipGetErrorString(e), grid);
}
```
